# Optimizing an MI355X kernel written in HIP

```python
import jax, jax.numpy as jnp
from jax import lax
import numpy as np

D_MODEL = 1024
BATCH = 2
SEQ = 8192
DEPTH = 2

GRID_W = 64
NA_HEADS = 8
NA_HEAD_DIM = 64
NA_WIDTH = NA_HEADS * NA_HEAD_DIM
NA_ROWS = 8
NA_COLS = 16
Q_BLOCK_COLS = 16
KEY_BAND_COLS = Q_BLOCK_COLS + NA_COLS
N_COL_BLOCKS = GRID_W // Q_BLOCK_COLS
F_GROUPS = 4
F_GROUP_DIM = 128
F_WIDTH = F_GROUPS * F_GROUP_DIM
IN_COLS = 3 * NA_WIDTH + F_WIDTH + 2 * D_MODEL
D_FF = 2816
RMS_EPS = 1e-6

kernel_name = "hybrid_na_fnet_macaron_encoder"


def rms_norm(x, g):
    xf = x.astype(jnp.float32)
    y = xf * lax.rsqrt(jnp.mean(xf * xf, axis=-1, keepdims=True) + RMS_EPS)
    return (y * g.astype(jnp.float32)).astype(x.dtype)


def swiglu(x, w_in, w_out):
    gu = x @ w_in
    g, u = jnp.split(gu, 2, axis=-1)
    return (jax.nn.silu(g) * u) @ w_out


def neighbourhood_attention(q, k, v, rpb):
    B, T, H, Dh = q.shape
    rows = T // GRID_W
    kh = min(NA_ROWS, rows)
    r = jnp.arange(rows)
    row_start = jnp.clip(r - kh // 2, 0, rows - kh)
    row_idx = row_start[:, None] + jnp.arange(kh)
    j = jnp.arange(N_COL_BLOCKS)
    band_start = jnp.clip(j * Q_BLOCK_COLS - NA_COLS // 2, 0, GRID_W - KEY_BAND_COLS)
    key_col = band_start[:, None] + jnp.arange(KEY_BAND_COLS)
    q_col = j[:, None] * Q_BLOCK_COLS + jnp.arange(Q_BLOCK_COLS)
    win_start = jnp.clip(q_col - NA_COLS // 2, 0, GRID_W - NA_COLS)
    col_ok = (key_col[:, None, :] >= win_start[..., None]) & (
        key_col[:, None, :] < win_start[..., None] + NA_COLS)

    qg = q.reshape(B, rows, N_COL_BLOCKS, Q_BLOCK_COLS, H, Dh)
    kg = k.reshape(B, rows, GRID_W, H, Dh)
    vg = v.reshape(B, rows, GRID_W, H, Dh)
    gi_r = row_idx[:, None, :, None]
    gi_c = key_col[None, :, None, :]
    k_win = kg[:, gi_r, gi_c]
    v_win = vg[:, gi_r, gi_c]

    dr = row_idx - r[:, None] + (NA_ROWS - 1)
    dc = jnp.clip(key_col[:, None, :] - q_col[..., None], -(NA_COLS - 1), NA_COLS - 1) + (NA_COLS - 1)
    bias = rpb[:, dr[:, None, None, :, None], dc[None, :, :, None, :]]
    bias = jnp.transpose(bias, (1, 2, 0, 3, 4, 5)).astype(jnp.float32)

    scale = Dh ** -0.5
    s = jnp.einsum('brjqhd,brjuvhd->brjhquv', qg, k_win).astype(jnp.float32) * scale + bias[None]
    s = jnp.where(col_ok[None, None, :, None, :, None, :], s, -jnp.inf)
    sh = s.shape
    p = jax.nn.softmax(s.reshape(sh[:-2] + (kh * KEY_BAND_COLS,)), axis=-1).reshape(sh)
    o = jnp.einsum('brjhquv,brjuvhd->brjqhd', p.astype(v.dtype), v_win)
    return o.reshape(B, T, H * Dh)


def fourier_mix(u):
    B, T, _ = u.shape
    ug = u.astype(jnp.float32).reshape(B, T, F_GROUPS, F_GROUP_DIM)
    f = jnp.fft.fft2(ug, axes=(1, 3), norm="ortho").real
    return f.reshape(B, T, F_WIDTH).astype(u.dtype)


def mixer(h, w_in, gate_bias, rpb, w_na_out, w_f_out, w_o):
    B, T, _ = h.shape
    z = h @ w_in
    s1 = NA_WIDTH
    q = z[..., :s1]
    k = z[..., s1:2 * s1]
    v = z[..., 2 * s1:3 * s1]
    uf = z[..., 3 * s1:3 * s1 + F_WIDTH]
    ga = z[..., 3 * s1 + F_WIDTH:3 * s1 + F_WIDTH + D_MODEL]
    gf = z[..., 3 * s1 + F_WIDTH + D_MODEL:]
    shp = (B, T, NA_HEADS, NA_HEAD_DIM)
    y_na = neighbourhood_attention(q.reshape(shp), k.reshape(shp), v.reshape(shp), rpb) @ w_na_out
    y_f = fourier_mix(uf) @ w_f_out
    g_na = jax.nn.sigmoid(ga + gate_bias[0])
    g_f = jax.nn.sigmoid(gf + gate_bias[1])
    return (g_na * y_na + g_f * y_f) @ w_o


def setup_inputs(seed: int = 0) -> dict:
    key = jax.random.key(seed)
    ks = jax.random.split(key, 20)
    L, D, F = DEPTH, D_MODEL, D_FF

    def w(k, shape, fan_in, mult=1.0):
        return jax.random.normal(k, shape, jnp.float32) * (mult * fan_in ** -0.5)

    def gain(k, shape):
        return 1.0 + 0.05 * jax.random.normal(k, shape, jnp.float32)

    return {
        "x": jax.random.normal(ks[0], (BATCH, SEQ, D), jnp.float32),
        "ffn1_norm": gain(ks[1], (L, D)),
        "ffn1_w_in": w(ks[2], (L, D, 2 * F), D),
        "ffn1_w_out": w(ks[3], (L, F, D), F),
        "mix_norm": gain(ks[4], (L, D)),
        "mix_w_in": w(ks[5], (L, D, IN_COLS), D),
        "mix_gate_bias": 0.1 * jax.random.normal(ks[6], (L, 2, D), jnp.float32),
        "na_rpb": 0.5 * jax.random.normal(ks[7], (L, NA_HEADS, 2 * NA_ROWS - 1, 2 * NA_COLS - 1), jnp.float32),
        "na_w_out": w(ks[8], (L, NA_WIDTH, D), NA_WIDTH),
        "f_w_out": w(ks[9], (L, F_WIDTH, D), F_WIDTH),
        "mix_w_o": w(ks[10], (L, D, D), D),
        "ffn2_norm": gain(ks[11], (L, D)),
        "ffn2_w_in": w(ks[12], (L, D, 2 * F), D),
        "ffn2_w_out": w(ks[13], (L, F, D), F),
        "final_norm": gain(ks[14], (D,)),
    }


def reference(x, ffn1_norm, ffn1_w_in, ffn1_w_out, mix_norm, mix_w_in, mix_gate_bias,
              na_rpb, na_w_out, f_w_out, mix_w_o, ffn2_norm, ffn2_w_in, ffn2_w_out,
              final_norm):
    for l in range(DEPTH):
        x = x + 0.5 * swiglu(rms_norm(x, ffn1_norm[l]), ffn1_w_in[l], ffn1_w_out[l])
        x = x + mixer(rms_norm(x, mix_norm[l]), mix_w_in[l], mix_gate_bias[l], na_rpb[l],
                      na_w_out[l], f_w_out[l], mix_w_o[l])
        x = x + 0.5 * swiglu(rms_norm(x, ffn2_norm[l]), ffn2_w_in[l], ffn2_w_out[l])
    return rms_norm(x, final_norm)
```

```cpp
#include <hip/hip_runtime.h>
#include <hip/hip_cooperative_groups.h>
#include <cstdio>
#include <cstdint>
namespace cg = cooperative_groups;

#define LAS __attribute__((address_space(3)))
typedef unsigned short bf16_t;
typedef short bf16x8 __attribute__((ext_vector_type(8)));
typedef float f32x4 __attribute__((ext_vector_type(4)));
typedef float f32x2 __attribute__((ext_vector_type(2)));
typedef unsigned u32x4 __attribute__((ext_vector_type(4)));
typedef unsigned u32x2 __attribute__((ext_vector_type(2)));

constexpr int NTOK = 16384, DM = 1024, DFF = 2816, SEQ = 8192;
constexpr int ZLD = 3072;
constexpr float RMS_EPS = 1e-6f;
constexpr float LOG2E = 1.4426950408889634f;

constexpr size_t MiB = 1u << 20;
constexpr size_t WS_TAB = 1 * MiB;
constexpr size_t WS_DT = 1 * MiB + 65536;
constexpr size_t WS_EB = 1 * MiB + 131072;
constexpr size_t WS_PART = 2 * MiB;
constexpr size_t WS_W1A = 4 * MiB, WS_W2A = 15 * MiB, WS_W1B = 21 * MiB, WS_W2B = 32 * MiB;
constexpr size_t WS_WIN = 38 * MiB, WS_WNA = 46 * MiB, WS_GT = 47 * MiB, WS_WO = 49 * MiB;
constexpr size_t WS_XB = 52 * MiB;
constexpr size_t WS_Z = 84 * MiB;
constexpr size_t WS_H = 84 * MiB;
constexpr size_t WS_VU = 180 * MiB;
constexpr size_t WS_XA = 212 * MiB;
constexpr size_t WS_END = 244 * MiB;

constexpr int LDS_BYTES = 147456;
constexpr int MISC_OFF = LDS_BYTES - 256;
#ifndef PROBE_DUP
#define PROBE_DUP 0
#endif
#ifndef PHMASK
#define PHMASK 0xFFFF
#endif

__device__ __forceinline__ unsigned cvt_pk_bf16(float lo, float hi) { unsigned r; asm volatile("v_cvt_pk_bf16_f32 %0, %1, %2" : "=v"(r) : "v"(lo), "v"(hi)); return r; }
__device__ __forceinline__ float bf_lo(unsigned w) { return __uint_as_float(w << 16); }
__device__ __forceinline__ float bf_hi(unsigned w) { return __uint_as_float(w & 0xffff0000u); }
__device__ __forceinline__ float fast_exp2(float x) { return __builtin_amdgcn_exp2f(x); }
__device__ __forceinline__ float fast_rcp(float x) { return __builtin_amdgcn_rcpf(x); }
__device__ __forceinline__ float sigmoidf_(float x) { return fast_rcp(1.0f + fast_exp2(-x * LOG2E)); }
__device__ __forceinline__ float sx(float v, int mask, int lane) { return __int_as_float(__builtin_amdgcn_ds_bpermute((lane ^ mask) << 2, __float_as_int(v))); }
__device__ __forceinline__ float wave_sum(float v, int lane) {
#pragma unroll
    for (int o = 1; o < 64; o <<= 1) v += sx(v, o, lane);
    return v;
}
__device__ __forceinline__ float row_rstd(const float* part, int row) {
    const f32x4 a = *(const f32x4*)(part + (size_t)row * 4);
    return rsqrtf(((a.x + a.y) + (a.z + a.w)) * (1.0f / 1024.0f) + RMS_EPS);
}
__device__ __forceinline__ unsigned lane_id_fresh() { unsigned ones = ~0u; asm volatile("" : "+s"(ones)); return __builtin_amdgcn_mbcnt_hi(ones, __builtin_amdgcn_mbcnt_lo(ones, 0u)); }
#define LDS_WAIT() asm volatile("s_waitcnt lgkmcnt(0)" ::: "memory")

namespace pg8 {
constexpr int BM = 256, BK = 64, HALF = 128, HTB = HALF * BK * 2, STAGE_BYTES = 8 * HTB, NXCD = 8, WGM = 8;
__host__ __device__ __forceinline__ int lds_byte(int r, int c) { const int st = (r >> 4) * 2 + (c >> 5), rr = r & 15, cc = c & 31, ob = rr * 64 + cc * 2; return st * 1024 + (ob ^ (((ob >> 9) & 1) << 5)); }
__host__ __device__ __forceinline__ void stage_rc(int b, int& R, int& C) { const int st = b / 1024, sb = b % 1024, swz = sb ^ (((sb >> 9) & 1) << 5); R = (st >> 1) * 16 + swz / 64; C = (st & 1) * 32 + (swz % 64) / 2; }
__host__ __device__ __forceinline__ int perm32(int rho) { const int n = rho >> 4, i = rho & 15; return 8 * (i >> 2) + 4 * n + (i & 3); }

struct Unit { int pm, pn, kind; };
struct Gemm { const bf16_t* A; const bf16_t* Bt; int M, N, K, lda, ldb; const bf16_t* A2; const bf16_t* Bt2; };

struct StaticOrder {
    int nM, nN, nwg, G, c;
    __host__ __device__ void init(int M, int N, int G_, int c_) { nM = M / BM; nN = N / BM; nwg = nM * nN; G = G_; c = c_; }
    __host__ __device__ bool next(int i, Unit& u) const { const long L = (long)i * G + c; if (L >= nwg) return false; map((int)L, u); return true; }
    __host__ __device__ void map(int L, Unit& u) const {
        int wgid = L; { const int q = nwg / NXCD, r = nwg % NXCD, xcd = wgid % NXCD, off = wgid / NXCD; wgid = (xcd < r ? xcd * (q + 1) : r * (q + 1) + (xcd - r) * q) + off; }
        const int nig = WGM * nN, gid = wgid / nig, fm = gid * WGM, gsz = (nM - fm) < WGM ? (nM - fm) : WGM;
        u.pm = fm + ((wgid % nig) % gsz); u.pn = (wgid % nig) / gsz; u.kind = 0;
    }
};
struct DualOrder {
    StaticOrder s1, s2;
    __device__ __forceinline__ bool next(int i, Unit& u) const {
        const int L = i * s1.G + s1.c;
        if (L < s1.nwg) { s1.map(L, u); return true; }
        if (L - s1.nwg < s2.nwg) { s2.map(L - s1.nwg, u); u.kind = 1; return true; }
        return false;
    }
};

typedef f32x4 Acc[2][2][4][2];

__device__ __forceinline__ u32x4 pack8(const f32x4 v0, const f32x4 v1) {
    u32x4 w; w.x = cvt_pk_bf16(v0[0], v0[1]); w.y = cvt_pk_bf16(v0[2], v0[3]); w.z = cvt_pk_bf16(v1[0], v1[1]); w.w = cvt_pk_bf16(v1[2], v1[3]); return w;
}

struct EpiSwiglu {
    static constexpr bool PERM = true; static constexpr bool HAS_PRE = true;
    bf16_t* H; const float* part;
    __device__ __forceinline__ f32x4 pre_load(const Unit& u, int tid) const { return *(const f32x4*)(part + (size_t)(u.pm * BM + (tid & 255)) * 4); }
    __device__ __forceinline__ void pre_store(const f32x4 a, int tid, LAS float* tab) const { if (tid < 256) tab[tid] = rsqrtf(((a.x + a.y) + (a.z + a.w)) * (1.0f / 1024.0f) + RMS_EPS); }
    __device__ __forceinline__ void operator()(const Acc& acc, const Unit& u, int wr, int wc, int fr, int fq, const LAS float* p) const {
        const int row0 = u.pm * BM + wr * 64 + fr, col0 = u.pn * HALF + wc * 32 + 8 * fq;
#pragma unroll
        for (int ai = 0; ai < 2; ++ai)
#pragma unroll
            for (int m = 0; m < 4; ++m) {
                const int row = row0 + ai * HALF + m * 16; const float rs = p[ai * HALF + wr * 64 + m * 16 + fr];
                f32x4 h[2];
#pragma unroll
                for (int n = 0; n < 2; ++n) {
                    const f32x4 g = acc[ai][0][m][n] * rs, up = acc[ai][1][m][n] * rs;
#pragma unroll
                    for (int j = 0; j < 4; ++j) h[n][j] = g[j] * sigmoidf_(g[j]) * up[j];
                }
                *(u32x4*)(H + (size_t)row * DFF + col0) = pack8(h[0], h[1]);
            }
    }
};
template <int ALPHA2, bool FIN> struct EpiResid {
    static constexpr bool PERM = true; static constexpr bool HAS_PRE = false;
    const float* base; float* out; bf16_t* xb; float* part;
    static constexpr float alpha = 0.5f * ALPHA2; static constexpr int fin = FIN ? 1 : 0;
    const float* gfin; unsigned* cnt;
    __device__ __forceinline__ void operator()(Acc& acc, const Unit& u, int wr, int wc, int fr, int fq) const {
        LAS float* P = (LAS float*)(uintptr_t)131072;
        const unsigned off0 = (unsigned)((u.pm * BM + wr * 64 + fr) * DM + u.pn * BM + wc * 32 + 8 * fq);
#pragma unroll
        for (int h4 = 0; h4 < 4; ++h4) {
            const int ai = h4 >> 1, mb = (h4 & 1) * 2;
            f32x4 pre[2][2][2];
#pragma unroll
            for (int mm = 0; mm < 2; ++mm)
#pragma unroll
                for (int bj = 0; bj < 2; ++bj)
#pragma unroll
                    for (int n = 0; n < 2; ++n) pre[mm][bj][n] = *(const f32x4*)(base + off0 + (unsigned)((ai * HALF + (mb + mm) * 16) * DM + bj * HALF + n * 4));
            asm volatile("" ::: "memory");
#pragma unroll
            for (int mm = 0; mm < 2; ++mm) {
                const int m = mb + mm;
                const unsigned off = off0 + (unsigned)((ai * HALF + m * 16) * DM); float ss = 0.f;
#pragma unroll
                for (int bj = 0; bj < 2; ++bj) {
                    const unsigned o2 = off + (unsigned)(bj * HALF);
                    const f32x4 o0 = pre[mm][bj][0] + acc[ai][bj][m][0] * alpha, o1 = pre[mm][bj][1] + acc[ai][bj][m][1] * alpha;
                    ss += ((o0[0] * o0[0] + o0[1] * o0[1]) + (o0[2] * o0[2] + o0[3] * o0[3])) + ((o1[0] * o1[0] + o1[1] * o1[1]) + (o1[2] * o1[2] + o1[3] * o1[3]));
                    if (!fin) { __builtin_nontemporal_store(o0, (f32x4*)(out + o2)); __builtin_nontemporal_store(o1, (f32x4*)(out + o2 + 4)); *(u32x4*)(xb + o2) = pack8(o0, o1); }
                    else { acc[ai][bj][m][0] = o0; acc[ai][bj][m][1] = o1; }
                }
                ss += sx(ss, 16, fr + 16 * fq); ss += sx(ss, 32, fr + 16 * fq);
                if (fq == 0) P[(ai * HALF + wr * 64 + m * 16 + fr) * 4 + wc] = ss;
            }
            asm volatile("" ::: "memory");
        }
        asm volatile("s_waitcnt lgkmcnt(0)" ::: "memory"); __builtin_amdgcn_s_barrier(); asm volatile("" ::: "memory");
        const int wid = wr * 4 + wc, lane = fq * 16 + fr, t = wid * 64 + lane;
        if (!fin) {
            if (t < 256) { const f32x4 p = *(const LAS f32x4*)(P + t * 4); part[(size_t)(u.pm * BM + t) * 4 + u.pn] = (p.x + p.y) + (p.z + p.w); }
        } else {
            LAS float* S = P + 1024; LAS unsigned* flag = (LAS unsigned*)(P + 1024 + 256);
            unsigned* pc = cnt + 64 * u.pm;
            if (t < 256) { const f32x4 p = *(const LAS f32x4*)(P + t * 4);
                __hip_atomic_store((unsigned*)part + (size_t)(u.pm * BM + t) * 4 + u.pn, __float_as_uint((p.x + p.y) + (p.z + p.w)), __ATOMIC_RELAXED, __HIP_MEMORY_SCOPE_AGENT); }
            asm volatile("s_waitcnt vmcnt(0)" ::: "memory");
            if (wid < 4 && lane == 0) __hip_atomic_fetch_add(pc, 1u, __ATOMIC_RELAXED, __HIP_MEMORY_SCOPE_AGENT);
            if (wid == 0) {
                unsigned spins = 0;
                while ((unsigned)__builtin_amdgcn_readfirstlane(__hip_atomic_load(pc, __ATOMIC_RELAXED, __HIP_MEMORY_SCOPE_AGENT)) < 16u && ++spins < (1u << 22)) __builtin_amdgcn_s_sleep(2);
                __builtin_amdgcn_fence(__ATOMIC_ACQUIRE, "agent");
                if (lane == 0) flag[0] = (spins >= (1u << 22)) ? 1u : 0u;
            }
            asm volatile("s_waitcnt vmcnt(0) lgkmcnt(0)" ::: "memory"); __builtin_amdgcn_s_barrier(); asm volatile("" ::: "memory");
            if (t < 256) {
                unsigned* sl = (unsigned*)part + (size_t)(u.pm * BM + t) * 4;
                const float a0 = __uint_as_float(__hip_atomic_load(sl + 0, __ATOMIC_RELAXED, __HIP_MEMORY_SCOPE_AGENT)), a1 = __uint_as_float(__hip_atomic_load(sl + 1, __ATOMIC_RELAXED, __HIP_MEMORY_SCOPE_AGENT));
                const float a2 = __uint_as_float(__hip_atomic_load(sl + 2, __ATOMIC_RELAXED, __HIP_MEMORY_SCOPE_AGENT)), a3 = __uint_as_float(__hip_atomic_load(sl + 3, __ATOMIC_RELAXED, __HIP_MEMORY_SCOPE_AGENT));
                S[t] = (flag[0] != 0u) ? __builtin_nanf("") : rsqrtf(((a0 + a1) + (a2 + a3)) * (1.0f / 1024.0f) + RMS_EPS);
            }
            asm volatile("s_waitcnt vmcnt(0) lgkmcnt(0)" ::: "memory"); __builtin_amdgcn_s_barrier(); asm volatile("" ::: "memory");
            f32x4 gv[2][2];
#pragma unroll
            for (int bj = 0; bj < 2; ++bj)
#pragma unroll
                for (int n = 0; n < 2; ++n) gv[bj][n] = *(const f32x4*)(gfin + u.pn * BM + wc * 32 + 8 * fq + bj * HALF + 4 * n);
#pragma unroll
            for (int ai = 0; ai < 2; ++ai)
#pragma unroll
                for (int m = 0; m < 4; ++m) {
                    const float rs = S[ai * HALF + wr * 64 + m * 16 + fr];
                    const unsigned off = off0 + (unsigned)((ai * HALF + m * 16) * DM);
#pragma unroll
                    for (int bj = 0; bj < 2; ++bj) {
                        *(f32x4*)(out + off + (unsigned)(bj * HALF)) = acc[ai][bj][m][0] * rs * gv[bj][0];
                        *(f32x4*)(out + off + (unsigned)(bj * HALF) + 4) = acc[ai][bj][m][1] * rs * gv[bj][1];
                    }
                }
        }
        asm volatile("s_waitcnt lgkmcnt(0)" ::: "memory"); __builtin_amdgcn_s_barrier(); asm volatile("" ::: "memory");
    }
};
struct EpiMixIn {
    static constexpr bool PERM = true; static constexpr bool HAS_PRE = false;
    bf16_t* Z; const float* part; const float* gbias;
    __device__ __forceinline__ void operator()(const Acc& acc, const Unit& u, int wr, int wc, int fr, int fq) const {
        const int row0 = u.pm * BM + wr * 64 + fr, col0 = u.pn * BM + wc * 32 + 8 * fq; const bool gate = u.pn >= 4, kt = (u.pn >> 1) == 1;
        f32x4 bv[2][2];
#pragma unroll
        for (int bj = 0; bj < 2; ++bj)
#pragma unroll
            for (int n = 0; n < 2; ++n) bv[bj][n] = gate ? *(const f32x4*)(gbias + (col0 - 1024) + bj * HALF + 4 * n) : (f32x4){0.f, 0.f, 0.f, 0.f};
        float rsv[2][4];
#pragma unroll
        for (int ai = 0; ai < 2; ++ai)
#pragma unroll
            for (int m = 0; m < 4; ++m) rsv[ai][m] = row_rstd(part, row0 + ai * HALF + m * 16);
#pragma unroll
        for (int ai = 0; ai < 2; ++ai)
#pragma unroll
            for (int m = 0; m < 4; ++m) {
                const int row = row0 + ai * HALF + m * 16; const float rs = rsv[ai][m];
#pragma unroll
                for (int bj = 0; bj < 2; ++bj) {
                    f32x4 v[2];
#pragma unroll
                    for (int n = 0; n < 2; ++n) {
                        v[n] = acc[ai][bj][m][n] * rs;
                        if (gate) {
                            v[n] = v[n] + bv[bj][n];
#pragma unroll
                            for (int j = 0; j < 4; ++j) v[n][j] = sigmoidf_(v[n][j]);
                        }
                    }
                    const int col = col0 + bj * HALF;
                    size_t zoff = (size_t)row * ZLD + col;
                    if (kt) {
                        const int hh = (col - 512) >> 6, d0 = (col - 512) & 63;
                        zoff = (size_t)(hh * 2048 + (row >> 3)) * ZLD + 512 + ((((((row >> 2) & 1) * 2 + (d0 >> 5)) * 4 + (row & 3)) * 4 + ((d0 >> 3) & 3)) * 8);
                    }
                    if (gate) __builtin_nontemporal_store(pack8(v[0], v[1]), (u32x4*)(Z + zoff)); else *(u32x4*)(Z + zoff) = pack8(v[0], v[1]);
                }
                if (m & 1) asm volatile("" ::: "memory");
            }
    }
};
struct EpiColScale {
    static constexpr bool PERM = true; static constexpr bool HAS_PRE = false;
    bf16_t* O; int ldc; const float* part;
    __device__ __forceinline__ void operator()(const Acc& acc, const Unit& u, int wr, int wc, int fr, int fq) const {
        const int row0 = u.pm * BM + wr * 64 + fr, col0 = u.pn * BM + wc * 32 + 8 * fq;
        f32x4 cs[2][2];
#pragma unroll
        for (int bj = 0; bj < 2; ++bj)
#pragma unroll
            for (int n = 0; n < 2; ++n)
#pragma unroll
                for (int j = 0; j < 4; ++j) cs[bj][n][j] = row_rstd(part, col0 + bj * HALF + 4 * n + j);
#pragma unroll
        for (int ai = 0; ai < 2; ++ai)
#pragma unroll
            for (int m = 0; m < 4; ++m) {
                const int row = row0 + ai * HALF + m * 16;
#pragma unroll
                for (int bj = 0; bj < 2; ++bj)
                {
                    const int col = col0 + bj * HALF;
                    size_t ooff = (size_t)row * ldc + col;
                    if (u.pm < 2) ooff = ((size_t)(((row >> 6) * 2048 + (col >> 3)) * 4 + ((row >> 4) & 3))) * 128 + (row & 15) * 8;
                    *(u32x4*)(O + ooff) = pack8(acc[ai][bj][m][0] * cs[bj][0], acc[ai][bj][m][1] * cs[bj][1]);
                }
            }
    }
};
struct EpiInDual {
    static constexpr bool PERM = true; static constexpr bool HAS_PRE = false;
    EpiMixIn e0; EpiColScale e1;
    __device__ __forceinline__ void operator()(const Acc& acc, const Unit& u, int wr, int wc, int fr, int fq) const { if (u.kind == 0) e0(acc, u, wr, wc, fr, fq); else e1(acc, u, wr, wc, fr, fq); }
};
template <bool ADD> struct EpiGate {
    static constexpr bool PERM = true; static constexpr bool HAS_PRE = false;
    const bf16_t* G; bf16_t* Mb;
    __device__ __forceinline__ void operator()(const Acc& acc, const Unit& u, int wr, int wc, int fr, int fq) const {
        const int row0 = u.pm * BM + wr * 64 + fr, col0 = u.pn * BM + wc * 32 + 8 * fq;
#pragma unroll
        for (int ai = 0; ai < 2; ++ai) {
            u32x4 gw[4][2], pw[4][2];
#pragma unroll
            for (int m = 0; m < 4; ++m)
#pragma unroll
                for (int bj = 0; bj < 2; ++bj) {
                    const int row = row0 + ai * HALF + m * 16;
                    gw[m][bj] = *(const u32x4*)(G + (size_t)row * ZLD + col0 + bj * HALF);
                    if (ADD) pw[m][bj] = *(const u32x4*)(Mb + (size_t)row * DM + col0 + bj * HALF);
                }
            asm volatile("" ::: "memory");
#pragma unroll
            for (int m = 0; m < 4; ++m)
#pragma unroll
                for (int bj = 0; bj < 2; ++bj) {
                    const int row = row0 + ai * HALF + m * 16;
                    bf16_t* mp = Mb + (size_t)row * DM + col0 + bj * HALF;
                    const u32x4 g4 = gw[m][bj];
                    f32x4 v0 = acc[ai][bj][m][0], v1 = acc[ai][bj][m][1];
                    v0[0] *= bf_lo(g4.x); v0[1] *= bf_hi(g4.x); v0[2] *= bf_lo(g4.y); v0[3] *= bf_hi(g4.y);
                    v1[0] *= bf_lo(g4.z); v1[1] *= bf_hi(g4.z); v1[2] *= bf_lo(g4.w); v1[3] *= bf_hi(g4.w);
                    if (ADD) {
                        const u32x4 p4 = pw[m][bj];
                        v0[0] += bf_lo(p4.x); v0[1] += bf_hi(p4.x); v0[2] += bf_lo(p4.y); v0[3] += bf_hi(p4.y);
                        v1[0] += bf_lo(p4.z); v1[1] += bf_hi(p4.z); v1[2] += bf_lo(p4.w); v1[3] += bf_hi(p4.w);
                    }
                    *(u32x4*)mp = pack8(v0, v1);
                }
            asm volatile("" ::: "memory");
        }
    }
};
struct EpiDftA {
    static constexpr bool PERM = true; static constexpr bool HAS_PRE = false;
    bf16_t* Ap; const f32x2* tab; float scale;
    __device__ __forceinline__ void operator()(const Acc& acc, const Unit& u, int wr, int wc, int fr, int fq) const {
        const int nb = u.pn * BM + wc * 32 + 8 * fq, t2 = nb & 63;
#pragma unroll
        for (int m = 0; m < 4; ++m) {
            const int k1 = wr * 64 + m * 16 + fr;
            f32x2 cs[8];
            cs[0] = tab[(unsigned)(k1 * t2)]; const f32x2 w = tab[(unsigned)k1];
            cs[0].x *= scale; cs[0].y *= scale;
#pragma unroll
            for (int e = 1; e < 8; ++e) { cs[e].x = cs[e - 1].x * w.x - cs[e - 1].y * w.y; cs[e].y = cs[e - 1].y * w.x + cs[e - 1].x * w.y; }
#pragma unroll
            for (int bj = 0; bj < 2; ++bj) {
                const int n0 = nb + bj * HALF, ch = (n0 >> 6) & 511, b = n0 >> 15;
                const unsigned doff = (unsigned)(((b * 64 + (k1 & 63)) * 512 + ch) * 256 + (k1 >> 6) * 128 + t2);
                f32x4 re[2], im[2];
#pragma unroll
                for (int n = 0; n < 2; ++n)
#pragma unroll
                    for (int j = 0; j < 4; ++j) {
                        const float ar = acc[0][bj][m][n][j], ai_ = acc[1][bj][m][n][j]; const f32x2 c = cs[4 * n + j];
                        re[n][j] = ar * c.x + ai_ * c.y; im[n][j] = ai_ * c.x - ar * c.y;
                    }
                *(u32x4*)(Ap + doff) = pack8(re[0], re[1]);
                *(u32x4*)(Ap + doff + 64) = pack8(im[0], im[1]);
            }
            asm volatile("" ::: "memory");
        }
    }
};
struct EpiDftB {
    static constexpr bool PERM = true; static constexpr bool HAS_PRE = false;
    bf16_t* FW; float scale;
    __device__ __forceinline__ void operator()(const Acc& acc, const Unit& u, int wr, int wc, int fr, int fq) const {
        const int nb = u.pn * BM + wc * 32 + 8 * fq;
#pragma unroll
        for (int bj = 0; bj < 2; ++bj) {
            const int n0 = nb + bj * HALF, ch = n0 & 511, k1lo = (n0 >> 9) & 63, b = n0 >> 15;
            const unsigned base = (unsigned)((b * SEQ + k1lo + 64 * wr + 128 * fr) * DM + ch);
#pragma unroll
            for (int ai = 0; ai < 2; ++ai)
#pragma unroll
                for (int m = 0; m < 4; ++m) {
                    *(u32x4*)(FW + base + (unsigned)(128 * 16 * m * DM + ai * 512)) = pack8(acc[ai][bj][m][0] * scale, acc[ai][bj][m][1] * scale);
                    if (m & 1) asm volatile("" ::: "memory");
                }
        }
    }
};

struct OneUnit { int pn; __device__ __forceinline__ bool next(int i, Unit& u) const { if (i) return false; u.pm = 0; u.pn = pn; u.kind = 0; return true; } };
template <class Epi, class Sched = StaticOrder>
__device__ __forceinline__ void gemm_phase(LAS unsigned char* lds, const Gemm g, const Sched& S, const Epi& E, const int wave_) {
    int tid = wave_ * 64 + (int)lane_id_fresh(); asm volatile("" : "+v"(tid));
    const int wid = __builtin_amdgcn_readfirstlane(tid >> 6), lane = tid & 63, wr = wid >> 2, wc = wid & 3, fr = lane & 15, fq = lane >> 4;
    int K = g.K;
    asm volatile("" : "+s"(K));
    const int nt = K / BK;
    unsigned voffA[2], voffB[2];
#pragma unroll
    for (int i = 0; i < 2; ++i) { int R, C; stage_rc(tid * 16 + i * 8192, R, C); const int Rb = Epi::PERM ? ((R & ~31) + perm32(R & 31)) : R;
        voffA[i] = (unsigned)(R * g.lda + C) * 2u; voffB[i] = (unsigned)(Rb * g.ldb + C) * 2u; }
    const size_t kstep = (size_t)(BK * 2);
    const size_t hstepA = (size_t)HALF * g.lda * 2, hstepB = (size_t)HALF * g.ldb * 2;
    const size_t tstepA = 2 * hstepA, tstepB = 2 * hstepB;
    const unsigned ldsw = (unsigned)wid * 1024u;
    const int aoff = lds_byte(wr * 64 + fr, fq * 8), boff = lds_byte(wc * 32 + fr, fq * 8);
#define PG8_SA(b, h) (((b) * 2 + (h)) * HTB)
#define PG8_SB(b, h) ((4 + (b) * 2 + (h)) * HTB)
#define PG8_STAGE(bufoff, gbase, voff) do { _Pragma("unroll") for (int _i = 0; _i < 2; ++_i) \
        __builtin_amdgcn_global_load_lds((const unsigned*)((const char*)(gbase) + (voff)[_i]), (LAS unsigned*)(lds + (bufoff) + ldsw + _i * 8192), 16, 0, 0); } while (0)
#define PG8_LDA(dst, b, h) do { _Pragma("unroll") for (int m = 0; m < 4; ++m) _Pragma("unroll") for (int k = 0; k < 2; ++k) dst[m][k] = *(const LAS bf16x8*)(lds + PG8_SA(b, h) + aoff + m * 2048 + k * 1024); } while (0)
#define PG8_LDB(dst, b, h) do { _Pragma("unroll") for (int n = 0; n < 2; ++n) _Pragma("unroll") for (int k = 0; k < 2; ++k) dst[n][k] = *(const LAS bf16x8*)(lds + PG8_SB(b, h) + boff + n * 2048 + k * 1024); } while (0)
#define PG8_MMA(ai, bj, At, Bt) do { __builtin_amdgcn_s_setprio(1); _Pragma("unroll") for (int m = 0; m < 4; ++m) _Pragma("unroll") for (int n = 0; n < 2; ++n) _Pragma("unroll") for (int k = 0; k < 2; ++k) \
        acc[ai][bj][m][n] = __builtin_amdgcn_mfma_f32_16x16x32_bf16(Bt[n][k], At[m][k], acc[ai][bj][m][n], 0, 0, 0); __builtin_amdgcn_s_setprio(0); } while (0)
#define PG8_WAIT_V(n) asm volatile("s_waitcnt vmcnt(" #n ")" ::: "memory")
#define PG8_WAIT_L(n) asm volatile("s_waitcnt lgkmcnt(" #n ")" ::: "memory")
#define PG8_BAR __builtin_amdgcn_s_barrier()
#define PG8_SCHED __builtin_amdgcn_sched_barrier(0)
    Unit cur, nxt; int ui = 0;
    if (!S.next(0, cur)) return;
    LAS float* ptab = (LAS float*)(uintptr_t)(131072 + 8192);
    if constexpr (Epi::HAS_PRE) { E.pre_store(E.pre_load(cur, tid), tid, ptab); asm volatile("s_waitcnt lgkmcnt(0)" ::: "memory"); __builtin_amdgcn_s_barrier(); }
    Acc acc;
#pragma unroll
    for (int a = 0; a < 2; ++a)
#pragma unroll
        for (int b = 0; b < 2; ++b)
#pragma unroll
            for (int m = 0; m < 4; ++m)
#pragma unroll
                for (int n = 0; n < 2; ++n) acc[a][b][m][n] = (f32x4){0.f, 0.f, 0.f, 0.f};
    bf16x8 At[4][2], B0[2][2], B1[2][2];
    const char* cA = (const char*)(cur.kind ? g.A2 : g.A) + (size_t)cur.pm * tstepA; const char* cB = (const char*)(cur.kind ? g.Bt2 : g.Bt) + (size_t)cur.pn * tstepB;
    PG8_STAGE(PG8_SB(0, 0), cB, voffB); PG8_STAGE(PG8_SB(0, 1), cB + hstepB, voffB); PG8_STAGE(PG8_SA(0, 0), cA, voffA); PG8_STAGE(PG8_SA(0, 1), cA + hstepA, voffA);
    if (wr == 1) PG8_BAR;
    PG8_WAIT_V(2); PG8_BAR;
    PG8_STAGE(PG8_SB(1, 0), cB + kstep, voffB); PG8_STAGE(PG8_SA(1, 0), cA + kstep, voffA); PG8_STAGE(PG8_SB(1, 1), cB + hstepB + kstep, voffB);
    PG8_WAIT_V(6); PG8_BAR;
    for (;;) {
        const bool has_next = S.next(ui + 1, nxt);
        const char* nA = has_next ? (const char*)(nxt.kind ? g.A2 : g.A) + (size_t)nxt.pm * tstepA : cA; const char* nB = has_next ? (const char*)(nxt.kind ? g.Bt2 : g.Bt) + (size_t)nxt.pn * tstepB : cB;
        for (int t = 0; t < nt; t += 2) {
            const bool last = (t == nt - 2);
            const char* a1 = cA + (size_t)(t + 1) * kstep;
            const char* a2 = last ? nA : cA + (size_t)(t + 2) * kstep; const char* b2 = last ? nB : cB + (size_t)(t + 2) * kstep;
            const char* a3 = a2 + kstep; const char* b3 = b2 + kstep;
            PG8_LDB(B0, 0, 0); PG8_LDB(B1, 0, 1); PG8_SCHED; PG8_LDA(At, 0, 0); PG8_STAGE(PG8_SA(1, 1), a1 + hstepA, voffA);
            PG8_WAIT_V(8); PG8_WAIT_L(0); PG8_BAR; PG8_MMA(0, 0, At, B0); PG8_MMA(0, 1, At, B1); PG8_BAR; PG8_SCHED;
            PG8_LDA(At, 0, 1); PG8_STAGE(PG8_SB(0, 0), b2, voffB); PG8_STAGE(PG8_SB(0, 1), b2 + hstepB, voffB); PG8_STAGE(PG8_SA(0, 0), a2, voffA);
            PG8_WAIT_V(8); PG8_WAIT_L(0); PG8_BAR; PG8_MMA(1, 0, At, B0); PG8_MMA(1, 1, At, B1); PG8_BAR; PG8_SCHED;
            PG8_LDB(B0, 1, 0); PG8_LDB(B1, 1, 1); PG8_SCHED; PG8_LDA(At, 1, 0); PG8_STAGE(PG8_SA(0, 1), a2 + hstepA, voffA);
            PG8_WAIT_V(8); PG8_WAIT_L(0); PG8_BAR; PG8_MMA(0, 0, At, B0); PG8_MMA(0, 1, At, B1); PG8_BAR; PG8_SCHED;
            PG8_LDA(At, 1, 1); PG8_STAGE(PG8_SB(1, 0), b3, voffB); PG8_STAGE(PG8_SB(1, 1), b3 + hstepB, voffB); PG8_STAGE(PG8_SA(1, 0), a3, voffA);
            PG8_WAIT_V(8); PG8_WAIT_L(0); PG8_BAR; PG8_MMA(1, 0, At, B0); PG8_MMA(1, 1, At, B1); PG8_BAR; PG8_SCHED;
        }
        if (wr == 0) PG8_BAR;
        if constexpr (Epi::HAS_PRE) {
            f32x4 raw = (f32x4){0.f, 0.f, 0.f, 0.f};
            if (has_next) raw = E.pre_load(nxt, tid);
            E(acc, cur, wr, wc, fr, fq, ptab + (ui & 1) * 256);
            if (has_next) E.pre_store(raw, tid, ptab + ((ui + 1) & 1) * 256);
        } else E(acc, cur, wr, wc, fr, fq);
        if (!has_next) break;
#pragma unroll
        for (int a = 0; a < 2; ++a)
#pragma unroll
            for (int b = 0; b < 2; ++b)
#pragma unroll
                for (int m = 0; m < 4; ++m)
#pragma unroll
                    for (int n = 0; n < 2; ++n) acc[a][b][m][n] = (f32x4){0.f, 0.f, 0.f, 0.f};
        cur = nxt; cA = nA; cB = nB; ++ui;
        if (wr == 1) PG8_BAR;
    }
    PG8_WAIT_V(0);
    PG8_BAR;
#undef PG8_SA
#undef PG8_SB
#undef PG8_STAGE
#undef PG8_LDA
#undef PG8_LDB
#undef PG8_MMA
#undef PG8_WAIT_V
#undef PG8_WAIT_L
#undef PG8_BAR
#undef PG8_SCHED
}
}

__device__ __forceinline__ unsigned f2bf(float f) { unsigned u = __builtin_bit_cast(unsigned, f); return (u + 0x7fffu + ((u >> 16) & 1u)) >> 16; }
__device__ __forceinline__ unsigned pk2(float lo, float hi) { return f2bf(lo) | (f2bf(hi) << 16); }
__device__ __forceinline__ int destrow(int mode, int n) {
    if (mode == 1) { const int isu = n >= DFF ? 1 : 0; const int h = n - DFF * isu; return ((h >> 7) << 8) + (isu << 7) + (h & 127); }
    if (mode == 2) return n < 1024 ? n : (n < 2048 ? n + 2048 : n - 1024);
    return n;
}
__device__ __forceinline__ void tr_item(const float* W, int K, int N, bf16_t* WT, int mode, const float* gain, LAS float* scr, int item, int lane) {
    const int nblk = N / 64, kb = item / nblk, nb = item % nblk, k0 = 64 * kb, n0 = 64 * nb;
    const int ln = (lane & 15) * 4, lk = lane >> 4;
#pragma unroll
    for (int i = 0; i < 16; ++i) { const int kk = 4 * i + lk; const f32x4 w = *(const f32x4*)(W + (size_t)(k0 + kk) * N + n0 + ln);
        LAS float* d = scr + kk * 65 + ln; d[0] = w.x; d[1] = w.y; d[2] = w.z; d[3] = w.w; }
    const int c = lane & 7;
    f32x4 g0 = (f32x4){1.f, 1.f, 1.f, 1.f}, g1 = g0;
    if (gain) { g0 = *(const f32x4*)(gain + k0 + 8 * c); g1 = *(const f32x4*)(gain + k0 + 8 * c + 4); }
    LDS_WAIT();
#pragma unroll
    for (int j = 0; j < 8; ++j) { const int n = (lane >> 3) + 8 * j; const LAS float* s = scr + (8 * c) * 65 + n;
        u32x4 o; o.x = pk2(s[0 * 65] * g0.x, s[1 * 65] * g0.y); o.y = pk2(s[2 * 65] * g0.z, s[3 * 65] * g0.w); o.z = pk2(s[4 * 65] * g1.x, s[5 * 65] * g1.y); o.w = pk2(s[6 * 65] * g1.z, s[7 * 65] * g1.w);
        *(u32x4*)(WT + (size_t)destrow(mode, n0 + n) * K + k0 + 8 * c) = o; }
    LDS_WAIT();
}

#define RLX_AGENT __ATOMIC_RELAXED, __HIP_MEMORY_SCOPE_AGENT
#define XB_TMO      128
#define XB_XCNT(j)  (256  + 64 * (j))
#define XB_XSUB(j)  (1280 + 64 * (j))
#define XB_XGEN(j)  (2304 + 64 * (j))
#define XB_TOP      3328
#define XB_TOPGEN   3392
#define XCD_BAR_WORDS 3456
#define XB_SPIN_CAP (1u << 18)

__device__ __forceinline__ unsigned xb_ld(unsigned* p)              { return __hip_atomic_load(p, __ATOMIC_RELAXED, __HIP_MEMORY_SCOPE_AGENT); }
__device__ __forceinline__ unsigned xb_add(unsigned* p, unsigned v) { return __hip_atomic_fetch_add(p, v, __ATOMIC_RELAXED, __HIP_MEMORY_SCOPE_AGENT); }
__device__ __forceinline__ unsigned xb_xcc_id() { return (unsigned)__builtin_amdgcn_s_getreg((3 << 11) | 20) & 0xFu; }
#define XB_SPIN(cond, bar) do { unsigned _sp = 0; while (cond) { __builtin_amdgcn_s_sleep(1); \
    if ((++_sp & 255u) == 0u) { if (xb_ld(&(bar)[XB_TMO])) break; if (_sp > XB_SPIN_CAP) { atomicAdd(&(bar)[XB_TMO], 1u); break; } } } } while (0)

struct XcdBarrier {
    unsigned* bar; unsigned x;
    volatile LAS unsigned* st;
};

__device__ __forceinline__ XcdBarrier xcd_barrier_post(unsigned* bar, volatile LAS unsigned* st) {
    XcdBarrier b; b.bar = bar; b.x = xb_xcc_id(); b.st = st;
    if (threadIdx.x == 0) (void)xb_add(&bar[XB_XCNT(b.x)], 1u);
    return b;
}
__device__ __forceinline__ void xcd_barrier_complete(unsigned* bar, unsigned x, unsigned& nloc, unsigned& nx) {
    const unsigned G = gridDim.x * gridDim.y * gridDim.z;
    unsigned sum, cnt, mine, sp = 0u;
    for (;;) {
        sum = 0u; cnt = 0u; mine = 0u;
#pragma unroll
        for (unsigned j = 0; j < 16; ++j) { const unsigned c = xb_ld(&bar[XB_XCNT(j)]); sum += c; cnt += (c > 0u) ? 1u : 0u; mine = (j == x) ? c : mine; }
        if (sum == G) break;
        __builtin_amdgcn_s_sleep(1);
        if ((++sp & 255u) == 0u) { if (xb_ld(&bar[XB_TMO])) break; if (sp > XB_SPIN_CAP) { atomicAdd(&bar[XB_TMO], 1u); break; } }
    }
    nloc = mine > 0u ? mine : 1u; nx = cnt > 0u ? cnt : 1u;
}

__device__ __forceinline__ void xcd_barrier(const XcdBarrier& b, const int wave_) {
    asm volatile("s_waitcnt vmcnt(0)" ::: "memory");
    __syncthreads();
    if (wave_ == 0 && lane_id_fresh() == 0u) {
        unsigned* bar = b.bar;
        __builtin_amdgcn_s_waitcnt(0);
        unsigned nloc = b.st[0], nx = b.st[1];
        if (nloc == 0u) { xcd_barrier_complete(bar, b.x, nloc, nx); b.st[0] = nloc; b.st[1] = nx; }
        const unsigned old = xb_add(&bar[XB_XSUB(b.x)], 1u);
        const unsigned gen = old / nloc;
        if (old + 1u == (gen + 1u) * nloc) {
            __builtin_amdgcn_fence(__ATOMIC_RELEASE, "agent");
            asm volatile("s_waitcnt vmcnt(0)" ::: "memory");
            const unsigned og = xb_add(&bar[XB_TOP], 1u);
            const unsigned tg = og / nx;
            if (og + 1u == (tg + 1u) * nx) xb_add(&bar[XB_TOPGEN], 1u);
            else XB_SPIN(xb_ld(&bar[XB_TOPGEN]) == tg, bar);
            __builtin_amdgcn_fence(__ATOMIC_ACQUIRE, "agent");
            xb_add(&bar[XB_XGEN(b.x)], 1u);
            asm volatile("s_waitcnt vmcnt(0)" ::: "memory");
        } else {
            XB_SPIN(xb_ld(&bar[XB_XGEN(b.x)]) == gen, bar);
            __builtin_amdgcn_fence(__ATOMIC_ACQUIRE, "agent");
            asm volatile("s_waitcnt vmcnt(0)" ::: "memory");
        }
    }
    __syncthreads();
}


struct Args { const float* in[15]; float* out; unsigned char* ws; };
typedef const __attribute__((address_space(4))) Args* KArgs;

struct TrDesc { const float* W; bf16_t* WT; const float* gain; int K, N, mode, r; };
__device__ __forceinline__ int tr_count(int sel) {
    return ((sel & 1) ? 1408 : 0) + ((sel & 2) ? 1408 : 0) + ((sel & 4) ? 704 : 0) + ((sel & 8) ? 704 : 0) + ((sel & 16) ? 1024 : 0) + ((sel & 32) ? 128 : 0) + ((sel & 64) ? 256 : 0);
}
__device__ __forceinline__ TrDesc tr_desc(KArgs ap, unsigned char* ws, int l, int sel, int item) {
    const int C0 = (sel & 1) ? 1408 : 0, C1 = (sel & 2) ? 1408 : 0, C2 = (sel & 4) ? 704 : 0, C3 = (sel & 8) ? 704 : 0, C4 = (sel & 16) ? 1024 : 0, C5 = (sel & 32) ? 128 : 0;
    TrDesc d; int r = item;
    if (r < C0) { d.W = ap->in[2] + (size_t)l * DM * 2 * DFF; d.WT = (bf16_t*)(ws + WS_W1A); d.gain = ap->in[1] + l * DM; d.K = DM; d.N = 2 * DFF; d.mode = 1; d.r = r; return d; } r -= C0;
    if (r < C1) { d.W = ap->in[12] + (size_t)l * DM * 2 * DFF; d.WT = (bf16_t*)(ws + WS_W1B); d.gain = ap->in[11] + l * DM; d.K = DM; d.N = 2 * DFF; d.mode = 1; d.r = r; return d; } r -= C1;
    if (r < C2) { d.W = ap->in[3] + (size_t)l * DFF * DM; d.WT = (bf16_t*)(ws + WS_W2A); d.gain = nullptr; d.K = DFF; d.N = DM; d.mode = 0; d.r = r; return d; } r -= C2;
    if (r < C3) { d.W = ap->in[13] + (size_t)l * DFF * DM; d.WT = (bf16_t*)(ws + WS_W2B); d.gain = nullptr; d.K = DFF; d.N = DM; d.mode = 0; d.r = r; return d; } r -= C3;
    if (r < C4) { d.W = ap->in[5] + (size_t)l * DM * 4096; d.WT = (bf16_t*)(ws + WS_WIN); d.gain = ap->in[4] + l * DM; d.K = DM; d.N = 4096; d.mode = 2; d.r = r; return d; } r -= C4;
    if (r < C5) { d.W = ap->in[8] + (size_t)l * 512 * DM; d.WT = (bf16_t*)(ws + WS_WNA); d.gain = nullptr; d.K = 512; d.N = DM; d.mode = 0; d.r = r; return d; } r -= C5;
    d.W = ap->in[10] + (size_t)l * DM * DM; d.WT = (bf16_t*)(ws + WS_WO); d.gain = nullptr; d.K = DM; d.N = DM; d.mode = 0; d.r = r; return d;
}
__device__ __forceinline__ void tr_load(const TrDesc& d, f32x4 (&w)[16], int lane) {
    const int nblk = d.N / 64, kb = d.r / nblk, nb = d.r % nblk, k0 = 64 * kb, n0 = 64 * nb;
    const unsigned loff = (unsigned)((lane >> 4) * d.N + (lane & 15) * 4);
    const float* wb = d.W + (size_t)k0 * d.N + n0;
#pragma unroll
    for (int i = 0; i < 16; ++i) w[i] = __builtin_nontemporal_load((const f32x4*)(wb + (size_t)(4 * i) * d.N + loff));
}
__device__ __forceinline__ void tr_store(const TrDesc& d, const f32x4 (&w)[16], LAS float* scr, int lane) {
    const int nblk = d.N / 64, kb = d.r / nblk, nb = d.r % nblk, k0 = 64 * kb, n0 = 64 * nb, ln = (lane & 15) * 4, lk = lane >> 4;
#pragma unroll
    for (int i = 0; i < 16; ++i) { LAS float* p = scr + (4 * i + lk) * 65 + ln; p[0] = w[i].x; p[1] = w[i].y; p[2] = w[i].z; p[3] = w[i].w; }
    const int c = lane & 7;
    f32x4 g0 = (f32x4){1.f, 1.f, 1.f, 1.f}, g1 = g0;
    if (d.gain) { g0 = *(const f32x4*)(d.gain + k0 + 8 * c); g1 = *(const f32x4*)(d.gain + k0 + 8 * c + 4); }
    LDS_WAIT();
#pragma unroll
    for (int j = 0; j < 8; ++j) { const int n = (lane >> 3) + 8 * j; const LAS float* s = scr + (8 * c) * 65 + n;
        u32x4 o; o.x = pk2(s[0 * 65] * g0.x, s[1 * 65] * g0.y); o.y = pk2(s[2 * 65] * g0.z, s[3 * 65] * g0.w); o.z = pk2(s[4 * 65] * g1.x, s[5 * 65] * g1.y); o.w = pk2(s[6 * 65] * g1.z, s[7 * 65] * g1.w);
        *(u32x4*)(d.WT + (size_t)destrow(d.mode, n0 + n) * d.K + k0 + 8 * c) = o; }
    LDS_WAIT();
}
__device__ __forceinline__ void conv_job(KArgs ap, unsigned char* ws, int l, int sel, int gwl, int ngw, LAS float* scr, int lane) {
    const int nit = tr_count(sel);
    for (int item = gwl; item < nit; item += ngw) { const TrDesc d = tr_desc(ap, ws, l, sel, item); f32x4 wa[16]; tr_load(d, wa, lane); tr_store(d, wa, scr, lane); }
}
__device__ __forceinline__ void g_job(const float* wf, bf16_t* Gt, LAS unsigned char* lds, int tid, int lane, int wave, int bxl, int nblk) {
    LAS float* tg = (LAS float*)lds; LAS float* strip = (LAS float*)(lds + 4096);
    __syncthreads();
    if (tid < 128) { tg[tid] = cospif((float)tid * (1.0f / 64.0f)); tg[128 + tid] = sinpif((float)tid * (1.0f / 64.0f)); }
    for (int bi = bxl; bi < 256; bi += nblk) {
        const int nc = bi & 15, g = (bi >> 4) & 3, combo = (bi >> 6) * 8 + wave, ri = combo >> 4, c0 = (combo & 15) * 8, n = nc * 64 + lane;
        __syncthreads();
#pragma unroll
        for (int i = 0; i < 4; ++i) { const int idx = tid + 512 * i, m = idx >> 4, n4 = (idx & 15) * 4;
            *(LAS f32x4*)(strip + m * 64 + n4) = *(const f32x4*)(wf + (size_t)(g * 128 + m) * DM + nc * 64 + n4); }
        __syncthreads();
        const LAS float* tp = tg + ri * 128;
        float acc8[8];
#pragma unroll
        for (int e = 0; e < 8; ++e) acc8[e] = 0.f;
#pragma unroll 8
        for (int m = 0; m < 128; ++m) { const float w = strip[m * 64 + lane];
#pragma unroll
            for (int e = 0; e < 8; ++e) acc8[e] += tp[((c0 + e) * m) & 127] * w; }
        const float sg = 0.08838834764831845f;
        u32x4 o; o.x = pk2(acc8[0] * sg, acc8[1] * sg); o.y = pk2(acc8[2] * sg, acc8[3] * sg); o.z = pk2(acc8[4] * sg, acc8[5] * sg); o.w = pk2(acc8[6] * sg, acc8[7] * sg);
        *(u32x4*)(Gt + (size_t)n * 1024 + ri * 512 + g * 128 + c0) = o;
    }
    __syncthreads();
}

__global__ void __launch_bounds__(512, 2) fwd_kernel(Args a) {
    extern __shared__ __attribute__((aligned(16))) unsigned char lds_raw[];
    LAS unsigned char* lds = (LAS unsigned char*)lds_raw;
    cg::grid_group grid = cg::this_grid();
    const int wave = __builtin_amdgcn_readfirstlane(threadIdx.x >> 6);
#define LAUNDER_TID() int tid = wave * 64 + (int)lane_id_fresh(); asm volatile("" : "+v"(tid)); const int lane = tid & 63
    constexpr int G = 256;
    const int bx0 = blockIdx.x;
    constexpr int NGW = G * 8;
#define PTRS() \
    KArgs ap = (KArgs)__builtin_amdgcn_kernarg_segment_ptr(); asm volatile("" : "+s"(ap)); \
    int bx_l = bx0; asm volatile("" : "+s"(bx_l)); const int bx = bx_l; const int gw = bx * 8 + wave; \
    unsigned char* ws = ap->ws; \
    const float* x_in = ap->in[0]; \
    float* R = ap->out; \
    f32x2* tab = (f32x2*)(ws + WS_TAB); \
    bf16_t* Dt = (bf16_t*)(ws + WS_DT); bf16_t* Eb = (bf16_t*)(ws + WS_EB); \
    float* part = (float*)(ws + WS_PART); \
    bf16_t* W1tA = (bf16_t*)(ws + WS_W1A); bf16_t* W1tB = (bf16_t*)(ws + WS_W1B); \
    bf16_t* W2tA = (bf16_t*)(ws + WS_W2A); bf16_t* W2tB = (bf16_t*)(ws + WS_W2B); \
    bf16_t* Wint = (bf16_t*)(ws + WS_WIN); bf16_t* Wna_t = (bf16_t*)(ws + WS_WNA); bf16_t* Gt = (bf16_t*)(ws + WS_GT); bf16_t* Wo_t = (bf16_t*)(ws + WS_WO); \
    bf16_t* xb = (bf16_t*)(ws + WS_XB); bf16_t* Z = (bf16_t*)(ws + WS_Z); bf16_t* H = (bf16_t*)(ws + WS_H); \
    bf16_t* VU = (bf16_t*)(ws + WS_VU); bf16_t* Ap = xb; bf16_t* Mb = VU; \
    bf16_t* Xa = (bf16_t*)(ws + WS_XA); bf16_t* FW = Xa;
    {
        unsigned* bw = (unsigned*)a.ws;
        if (bx0 == 0) for (int i = threadIdx.x; i < 8192; i += 512) __hip_atomic_store(bw + i, 0u, RLX_AGENT);
        volatile LAS unsigned* misc = (volatile LAS unsigned*)(lds + MISC_OFF);
        if (threadIdx.x < 32) misc[threadIdx.x] = 0u;
        __threadfence();
        grid.sync();
    }
    XcdBarrier xbar = xcd_barrier_post((unsigned*)a.ws, (volatile LAS unsigned*)(lds + MISC_OFF) + 8);
#define GRID_SYNC() xcd_barrier(xbar, wave)

    for (int it = 0; it < 4; ++it) {
        const int l = it >> 1, which = it & 1;
        if (it == 0) {
            for (int rep = 0; rep < 1 + ((PROBE_DUP >> 0) & 1); ++rep) {
            if constexpr ((PHMASK >> 9) & 1) {
                LAUNDER_TID(); PTRS();
                conv_job(ap, ws, 0, 1, gw, NGW, (LAS float*)(lds + wave * 16640), lane);
                g_job(ap->in[9], Gt, lds, tid, lane, wave, bx, 256);
                __syncthreads();
                if (l == 0) {
                    for (int p = bx * 512 + tid; p < 8192; p += G * 512) { const float ang = (float)p * (1.0f / 4096.0f); tab[p] = (f32x2){cospif(ang), sinpif(ang)}; }
                    for (int i = bx * 512 + tid; i < 256 * 128; i += G * 512) {
                        const int row = i >> 7, t1 = i & 127, ri = row >> 7, k1 = row & 127; const float ang = (float)((k1 * t1) & 127) * (1.0f / 64.0f);
                        Dt[i] = (bf16_t)f2bf(ri == 0 ? cospif(ang) : -sinpif(ang));
                    }
                    for (int i = bx * 512 + tid; i < 256 * 256; i += G * 512) {
                        const int row = i >> 8, kap = i & 255, rio = row >> 7, p = (row >> 6) & 1, k2 = row & 63, pp = kap >> 7, rii = (kap >> 6) & 1, t2 = kap & 63;
                        const float ang = (float)((k2 * t2) & 63) * (1.0f / 32.0f); const float cv = cospif(ang), sv = sinpif(ang);
                        float v = 0.f; if (p == pp) v = (rio == 0) ? (rii == 0 ? cv : sv) : (rii == 0 ? -sv : cv);
                        Eb[i] = (bf16_t)f2bf(v);
                    }
                    for (int row = gw; row < NTOK; row += NGW) {
                        const f32x4* xr = (const f32x4*)(x_in + (size_t)row * DM) + lane; float s = 0.f;
                        unsigned long long* o8 = (unsigned long long*)(xb + (size_t)row * DM) + lane;
#pragma unroll
                        for (int j = 0; j < 4; ++j) { const f32x4 v = xr[64 * j]; s += (v.x * v.x + v.y * v.y) + (v.z * v.z + v.w * v.w);
                            o8[64 * j] = (unsigned long long)pk2(v.x, v.y) | ((unsigned long long)pk2(v.z, v.w) << 32); }
                        s = wave_sum(s, lane);
                        if (lane < 4) part[(size_t)row * 4 + lane] = lane == 0 ? s : 0.f;
                    }
                }
            }
            GRID_SYNC(); }
        }
            for (int rep = 0; rep < 1 + ((PROBE_DUP >> 1) & 1); ++rep) {
        {
            PTRS();
            pg8::Gemm g{xb, (which ? W1tB : W1tA), NTOK, 2 * DFF, DM, DM, DM, nullptr, nullptr}; pg8::StaticOrder S; S.init(NTOK, 2 * DFF, G, bx);
            pg8::EpiSwiglu E{H, part};
            if constexpr ((PHMASK >> 0) & 1) pg8::gemm_phase<pg8::EpiSwiglu>(lds, g, S, E, wave);
            if (bx >= 128) {
                LAUNDER_TID();
                const int gwl = (bx - 128) * 8 + wave; LAS float* scr = (LAS float*)(lds + wave * 16640);
                if (it == 0) conv_job(ap, ws, 0, 0x76, gwl, 1024, scr, lane);
                else if (it == 1) { conv_job(ap, ws, 0, 0x08, gwl, 1024, scr, lane); conv_job(ap, ws, 1, 0x71, gwl, 1024, scr, lane); }
                else if (it == 2) conv_job(ap, ws, 1, 0x06, gwl, 1024, scr, lane);
                else conv_job(ap, ws, 1, 0x08, gwl, 1024, scr, lane);
                if (it == 2) g_job(ap->in[9] + (size_t)512 * DM, Gt, lds, tid, lane, wave, bx - 128, 128);
            }
        }
        GRID_SYNC(); }
        for (int rep = 0; rep < 1 + ((PROBE_DUP >> 7) & 1); ++rep) {
        {
            PTRS();
            pg8::Gemm g{H, (which ? W2tB : W2tA), NTOK, DM, DFF, DFF, DFF, nullptr, nullptr}; pg8::StaticOrder S; S.init(NTOK, DM, G, bx);
            const bool probe0 = ((PROBE_DUP >> 7) & 1) && rep == 0;
            if (((PROBE_DUP >> 7) & 1) && probe0) {
                pg8::EpiResid<0, false> E{(it == 0) ? x_in : (const float*)R, R, xb, part, nullptr, nullptr};
                if constexpr ((PROBE_DUP >> 7) & 1) pg8::gemm_phase<pg8::EpiResid<0, false>>(lds, g, S, E, wave);
            } else if (it == 3) {
                pg8::EpiResid<1, true> E{(const float*)R, R, xb, part, ap->in[14], (unsigned*)(ws + 16384)};
                if constexpr ((PHMASK >> 1) & 1) pg8::gemm_phase<pg8::EpiResid<1, true>>(lds, g, S, E, wave);
            } else {
                pg8::EpiResid<1, false> E{(it == 0) ? x_in : (const float*)R, R, xb, part, nullptr, nullptr};
                if constexpr ((PHMASK >> 1) & 1) pg8::gemm_phase<pg8::EpiResid<1, false>>(lds, g, S, E, wave);
            }
        }
        if (it < 3 || ((PROBE_DUP >> 7) & 1)) GRID_SYNC(); }
        if (which == 0) {
            for (int rep = 0; rep < 1 + ((PROBE_DUP >> 2) & 1); ++rep) {
            {
                PTRS();
                pg8::Gemm g{xb, Wint, NTOK, 3072, DM, DM, DM, Wint + (size_t)3072 * DM, xb};
                pg8::DualOrder S; S.s1.init(NTOK, 3072, G, bx); S.s2.init(1024, NTOK, G, bx);
                pg8::EpiInDual E{pg8::EpiMixIn{Z, part, ap->in[6] + (size_t)l * 2048}, pg8::EpiColScale{VU, NTOK, part}};
                if constexpr ((PHMASK >> 2) & 1) pg8::gemm_phase<pg8::EpiInDual, pg8::DualOrder>(lds, g, S, E, wave);
            }
            GRID_SYNC(); }
            for (int rep = 0; rep < 1 + ((PROBE_DUP >> 3) & 1); ++rep) {
            if constexpr ((PHMASK >> 8) & 1) {
                LAUNDER_TID(); PTRS();
                LAS unsigned char* scr = lds + 16384 + wave * 9216;
                for (int item = gw; item < 2048; item += NGW) {
                    const int hq = item & 1, ch = (item >> 1) & 511, b = item >> 10;
                    const bf16_t* src = VU + (size_t)(512 + ch) * NTOK + b * SEQ + hq * 4096;
#pragma unroll
                    for (int i = 0; i < 8; ++i) { const int c = lane + 64 * i; const u32x4 v = *(const u32x4*)(src + c * 8); *(LAS u32x4*)(scr + (c >> 3) * 144 + (c & 7) * 16) = v; }
                    LDS_WAIT();
#pragma unroll
                    for (int ps = 0; ps < 8; ++ps) {
                        const int t2 = 8 * ps + (lane >> 3), q = lane & 7; unsigned e[8];
#pragma unroll
                        for (int k = 0; k < 8; ++k) e[k] = *(const LAS unsigned short*)(scr + (8 * q + k) * 144 + 2 * t2);
                        u32x4 o; o.x = e[0] | (e[1] << 16); o.y = e[2] | (e[3] << 16); o.z = e[4] | (e[5] << 16); o.w = e[6] | (e[7] << 16);
                        *(u32x4*)(Xa + ((size_t)((b * 512 + ch) * 64 + t2)) * 128 + hq * 64 + 8 * q) = o;
                    }
                    LDS_WAIT();
                }
                asm volatile("s_waitcnt vmcnt(0)" ::: "memory"); __syncthreads();
                if constexpr ((PHMASK >> 4) & 1) {
                    pg8::Gemm g{Dt, Xa, 256, 65536, 128, 128, 128, nullptr, nullptr}; pg8::OneUnit S1{bx};
                    pg8::EpiDftA E{Ap, tab, 0.08838834764831845f};
                    pg8::gemm_phase<pg8::EpiDftA, pg8::OneUnit>(lds, g, S1, E, wave);
                }
                LAS float* tb = (LAS float*)lds;
                const float* rpb = ap->in[7] + (size_t)l * 8 * 15 * 31;
                for (int i = tid; i < 8 * 15 * 32; i += 512) tb[i] = ((i & 31) < 31) ? rpb[(i >> 5) * 31 + (i & 31)] * LOG2E : -INFINITY;
                __syncthreads();
                const int q = lane & 15, gq = lane >> 4;
                for (int pass = 0; pass < 4; ++pass) {
                    const int up = pass * 256 + (bx >> 3) * 8 + wave;
                    const int h = bx & 7, j = up & 3, r = (up >> 2) & 127, b = up >> 9;
                    const int rowq = b * SEQ + r * 64 + 16 * j + q;
                    const bf16_t* qp = Z + (size_t)rowq * ZLD + h * 64 + 8 * gq;
                    const bf16x8 qf0 = *(const bf16x8*)qp, qf1 = *(const bf16x8*)(qp + 32);
                    const int rs = min(max(r - 4, 0), 120), bs = min(max(16 * j - 8, 0), 32);
                    f32x4 s[8][2];
                    const int kap_lo = 8 * (q >> 2) + (q & 3);
                    const int G0 = (b * SEQ + rs * 64 + bs) >> 3;
                    const unsigned klane = (unsigned)((q >> 2) * ZLD + (q & 3) * 32 + 8 * gq), vlane = (unsigned)(gq * 512 + q * 8);
                    const bf16_t* kb0 = Z + (size_t)(h * 2048 + G0) * ZLD + 512;
                    const bf16_t* vb0 = VU + (size_t)(h * 2048 + G0) * 512;
                    bf16x8 kf[8][2][2];
#pragma unroll
                    for (int u = 0; u < 8; ++u)
#pragma unroll
                        for (int tau = 0; tau < 2; ++tau) {
                            const bf16_t* kp = kb0 + (size_t)(u * 8) * ZLD + tau * 256 + klane;
                            kf[u][tau][0] = *(const bf16x8*)kp; kf[u][tau][1] = *(const bf16x8*)(kp + 128);
                        }
                    __builtin_amdgcn_sched_barrier(0);
#pragma unroll
                    for (int u = 0; u < 8; ++u)
#pragma unroll
                        for (int tau = 0; tau < 2; ++tau) {
                            f32x4 c = (f32x4){0.f, 0.f, 0.f, 0.f};
                            c = __builtin_amdgcn_mfma_f32_16x16x32_bf16(kf[u][tau][0], qf0, c, 0, 0, 0);
                            c = __builtin_amdgcn_mfma_f32_16x16x32_bf16(kf[u][tau][1], qf1, c, 0, 0, 0);
                            s[u][tau] = c;
                        }
                    __builtin_amdgcn_sched_barrier(0);
                    bf16x8 vf[8][4];
#pragma unroll
                    for (int u = 0; u < 8; ++u)
#pragma unroll
                        for (int mt = 0; mt < 4; ++mt) vf[u][mt] = *(const bf16x8*)(vb0 + (size_t)(u * 8) * 512 + mt * 128 + vlane);
                    __builtin_amdgcn_sched_barrier(0);
                    const int qcol = 16 * j + q, wst = min(max(qcol - 8, 0), 48);
                    int adr[8];
#pragma unroll
                    for (int k = 0; k < 8; ++k) {
                        const int kc = bs + 8 * gq + k; const int dc = min(max(kc - qcol, -15), 15) + 15;
                        adr[k] = ((h * 15 + (rs - r + 7)) * 32 + ((kc < wst || kc >= wst + 16) ? 31 : dc)) * 4;
                    }
                    float mx = -INFINITY;
#pragma unroll
                    for (int u = 0; u < 8; ++u)
#pragma unroll
                        for (int tau = 0; tau < 2; ++tau)
#pragma unroll
                            for (int i = 0; i < 4; ++i) {
                                const float bias = *(const LAS float*)((const LAS unsigned char*)tb + adr[4 * tau + i] + u * 128);
                                const float v = s[u][tau][i] * (0.125f * LOG2E) + bias;
                                s[u][tau][i] = v; mx = fmaxf(mx, v);
                            }
                    mx = fmaxf(mx, sx(mx, 16, lane)); mx = fmaxf(mx, sx(mx, 32, lane));
                    float sum = 0.f;
#pragma unroll
                    for (int u = 0; u < 8; ++u)
#pragma unroll
                        for (int tau = 0; tau < 2; ++tau)
#pragma unroll
                            for (int i = 0; i < 4; ++i) { const float p = fast_exp2(s[u][tau][i] - mx); s[u][tau][i] = p; sum += p; }
                    sum += sx(sum, 16, lane); sum += sx(sum, 32, lane);
                    f32x4 o[4];
#pragma unroll
                    for (int mt = 0; mt < 4; ++mt) o[mt] = (f32x4){0.f, 0.f, 0.f, 0.f};
#pragma unroll
                    for (int u = 0; u < 8; ++u) {
                        const u32x4 pw = pg8::pack8(s[u][0], s[u][1]);
                        const bf16x8 pb = __builtin_bit_cast(bf16x8, pw);
#pragma unroll
                        for (int mt = 0; mt < 4; ++mt) {
                            o[mt] = __builtin_amdgcn_mfma_f32_16x16x32_bf16(vf[u][mt], pb, o[mt], 0, 0, 0);
                        }
                    }
                    const float inv = 1.0f / sum;
                    if (((PROBE_DUP >> 3) & 1) && rep == 0 && inv > 0.f) continue;
#pragma unroll
                    for (int mt = 0; mt < 4; ++mt) {
                        u32x2 w; w.x = cvt_pk_bf16(o[mt][0] * inv, o[mt][1] * inv); w.y = cvt_pk_bf16(o[mt][2] * inv, o[mt][3] * inv);
                        *(u32x2*)(Z + (size_t)rowq * ZLD + h * 64 + 16 * mt + 4 * gq) = w;
                    }
                }
                __syncthreads();
            }
            GRID_SYNC(); }
            for (int rep = 0; rep < 1 + ((PROBE_DUP >> 5) & 1); ++rep) {
            {
                PTRS();
                pg8::Gemm g{Eb, Ap, 256, 65536, 256, 256, 256, nullptr, nullptr}; pg8::StaticOrder S; S.init(256, 65536, G, bx);
                pg8::EpiDftB E{FW, 0.125f};
                if constexpr ((PHMASK >> 5) & 1) pg8::gemm_phase<pg8::EpiDftB>(lds, g, S, E, wave);
            }
            GRID_SYNC(); }
            for (int rep = 0; rep < 1 + ((PROBE_DUP >> 6) & 1); ++rep) {
            {
                PTRS();
                pg8::Gemm g{Z, Wna_t, NTOK, DM, 512, ZLD, 512, nullptr, nullptr}; pg8::StaticOrder S; S.init(NTOK, DM, G, bx);
                pg8::EpiGate<false> E{Z + 1024, Mb};
                if constexpr ((PHMASK >> 6) & 1) pg8::gemm_phase<pg8::EpiGate<false>>(lds, g, S, E, wave);
            }
            {
                PTRS();
                pg8::Gemm g{FW, Gt, NTOK, DM, DM, DM, DM, nullptr, nullptr}; pg8::StaticOrder S; S.init(NTOK, DM, G, bx);
                pg8::EpiGate<true> E{Z + 2048, Mb};
                if constexpr ((PHMASK >> 7) & 1) pg8::gemm_phase<pg8::EpiGate<true>>(lds, g, S, E, wave);
            }
            GRID_SYNC(); }
            for (int rep = 0; rep < 1 + ((PROBE_DUP >> 8) & 1); ++rep) {
            {
                PTRS();
                pg8::Gemm g{Mb, Wo_t, NTOK, DM, DM, DM, DM, nullptr, nullptr}; pg8::StaticOrder S; S.init(NTOK, DM, G, bx);
                if (((PROBE_DUP >> 8) & 1) && rep == 0) {
                    pg8::EpiResid<0, false> E{R, R, xb, part, nullptr, nullptr};
                    if constexpr ((PROBE_DUP >> 8) & 1) pg8::gemm_phase<pg8::EpiResid<0, false>>(lds, g, S, E, wave);
                } else {
                    pg8::EpiResid<2, false> E{R, R, xb, part, nullptr, nullptr};
                    if constexpr ((PHMASK >> 1) & 1) pg8::gemm_phase<pg8::EpiResid<2, false>>(lds, g, S, E, wave);
                }
            }
            GRID_SYNC(); }
        }
    }
#ifdef PROBE_SYNC
    for (int i = 0; i < PROBE_SYNC; ++i) GRID_SYNC();
#endif
}

extern "C" void kernel_launch(void* const* d_in, const int* in_sizes, int n_in, void* d_out, int out_size, void* d_ws, size_t ws_size, hipStream_t stream) {
    static int grid = 0;
    if (grid == 0) {
        if (n_in != 15 || out_size != NTOK * DM || ws_size < WS_END) { fprintf(stderr, "kernel_launch: unexpected shapes (n_in %d out %d ws %zu)\n", n_in, out_size, ws_size); grid = -1; return; }
        int dev = 0, cus = 0, per_cu = 0;
        hipGetDevice(&dev); hipDeviceGetAttribute(&cus, hipDeviceAttributeMultiprocessorCount, dev);
        if (hipFuncSetAttribute((const void*)fwd_kernel, hipFuncAttributeMaxDynamicSharedMemorySize, LDS_BYTES) != hipSuccess) { fprintf(stderr, "kernel_launch: hipFuncSetAttribute failed\n"); grid = -1; return; }
        if (hipOccupancyMaxActiveBlocksPerMultiprocessor(&per_cu, (const void*)fwd_kernel, 512, LDS_BYTES) != hipSuccess || per_cu < 1) { fprintf(stderr, "kernel_launch: occupancy query says %d\n", per_cu); (void)hipGetLastError(); grid = -1; return; }
        if (cus * per_cu < 256) { fprintf(stderr, "kernel_launch: needs 256 co-resident workgroups, device holds %d\n", cus * per_cu); grid = -1; return; }
        grid = 256;
    }
    if (grid < 0) return;
    Args a{};
    for (int i = 0; i < 15; ++i) a.in[i] = (const float*)d_in[i];
    a.out = (float*)d_out; a.ws = (unsigned char*)d_ws;
    void* args[] = {&a};
    hipError_t e = hipLaunchCooperativeKernel((const void*)fwd_kernel, dim3(grid), dim3(512), args, LDS_BYTES, stream);
    if (e != hipSuccess) fprintf(stderr, "cooperative launch failed: %s (grid %d)\n", hipGetErrorString(e), grid);
}
```

```cpp
#include <hip/hip_runtime.h>
#include <hip/hip_cooperative_groups.h>
#include <cstdio>
#include <cstdint>
namespace cg = cooperative_groups;

#define LAS __attribute__((address_space(3)))
typedef unsigned short bf16_t;
typedef short bf16x8 __attribute__((ext_vector_type(8)));
typedef float f32x4 __attribute__((ext_vector_type(4)));
typedef float f32x2 __attribute__((ext_vector_type(2)));
typedef unsigned u32x4 __attribute__((ext_vector_type(4)));
typedef unsigned u32x2 __attribute__((ext_vector_type(2)));

constexpr int NTOK = 16384, DM = 1024, DFF = 2816, SEQ = 8192;
constexpr int ZLD = 3072;
constexpr float RMS_EPS = 1e-6f;
constexpr float LOG2E = 1.4426950408889634f;

constexpr size_t MiB = 1u << 20;
constexpr size_t WS_TAB = 1 * MiB;
constexpr size_t WS_DT = 1 * MiB + 65536;
constexpr size_t WS_EB = 1 * MiB + 131072;
constexpr size_t WS_PART = 2 * MiB;
constexpr size_t WS_W1A = 4 * MiB, WS_W2A = 15 * MiB, WS_W1B = 21 * MiB, WS_W2B = 32 * MiB;
constexpr size_t WS_WIN = 38 * MiB, WS_WNA = 46 * MiB, WS_GT = 47 * MiB, WS_WO = 49 * MiB;
constexpr size_t WS_XB = 52 * MiB;
constexpr size_t WS_Z = 84 * MiB;
constexpr size_t WS_H = 84 * MiB;
constexpr size_t WS_VU = 180 * MiB;
constexpr size_t WS_XA = 212 * MiB;
constexpr size_t WS_END = 244 * MiB;

constexpr int LDS_BYTES = 147456;
constexpr int MISC_OFF = LDS_BYTES - 256;
#ifndef PROBE_DUP
#define PROBE_DUP 0
#endif
#ifndef PHMASK
#define PHMASK 0xFFFF
#endif

__device__ __forceinline__ unsigned cvt_pk_bf16(float lo, float hi) { unsigned r; asm volatile("v_cvt_pk_bf16_f32 %0, %1, %2" : "=v"(r) : "v"(lo), "v"(hi)); return r; }
__device__ __forceinline__ float bf_lo(unsigned w) { return __uint_as_float(w << 16); }
__device__ __forceinline__ float bf_hi(unsigned w) { return __uint_as_float(w & 0xffff0000u); }
__device__ __forceinline__ float fast_exp2(float x) { return __builtin_amdgcn_exp2f(x); }
__device__ __forceinline__ float fast_rcp(float x) { return __builtin_amdgcn_rcpf(x); }
__device__ __forceinline__ float sigmoidf_(float x) { return fast_rcp(1.0f + fast_exp2(-x * LOG2E)); }
__device__ __forceinline__ float sx(float v, int mask, int lane) { return __int_as_float(__builtin_amdgcn_ds_bpermute((lane ^ mask) << 2, __float_as_int(v))); }
__device__ __forceinline__ float wave_sum(float v, int lane) {
#pragma unroll
    for (int o = 1; o < 64; o <<= 1) v += sx(v, o, lane);
    return v;
}
__device__ __forceinline__ float row_rstd(const float* part, int row) {
    const f32x4 a = *(const f32x4*)(part + (size_t)row * 4);
    return rsqrtf(((a.x + a.y) + (a.z + a.w)) * (1.0f / 1024.0f) + RMS_EPS);
}
__device__ __forceinline__ unsigned lane_id_fresh() { unsigned ones = ~0u; asm volatile("" : "+s"(ones)); return __builtin_amdgcn_mbcnt_hi(ones, __builtin_amdgcn_mbcnt_lo(ones, 0u)); }
#define WT_RSRC(ptr, bytes) __builtin_amdgcn_make_buffer_rsrc((void*)(ptr), (short)0, (int)(bytes), 0x00020000)
#define WT16(rsrc, off_bytes, val) __builtin_amdgcn_raw_buffer_store_b128((val), (rsrc), (unsigned)(off_bytes), 0, 16)
#define LDS_WAIT() asm volatile("s_waitcnt lgkmcnt(0)" ::: "memory")

namespace pg8 {
constexpr int BM = 256, BK = 64, HALF = 128, HTB = HALF * BK * 2, STAGE_BYTES = 8 * HTB, NXCD = 8, WGM = 8;
__host__ __device__ __forceinline__ int lds_byte(int r, int c) { const int st = (r >> 4) * 2 + (c >> 5), rr = r & 15, cc = c & 31, ob = rr * 64 + cc * 2; return st * 1024 + (ob ^ (((ob >> 9) & 1) << 5)); }
__host__ __device__ __forceinline__ void stage_rc(int b, int& R, int& C) { const int st = b / 1024, sb = b % 1024, swz = sb ^ (((sb >> 9) & 1) << 5); R = (st >> 1) * 16 + swz / 64; C = (st & 1) * 32 + (swz % 64) / 2; }
__host__ __device__ __forceinline__ int perm32(int rho) { const int n = rho >> 4, i = rho & 15; return 8 * (i >> 2) + 4 * n + (i & 3); }

struct Unit { int pm, pn, kind; };
struct Gemm { const bf16_t* A; const bf16_t* Bt; int M, N, K, lda, ldb; const bf16_t* A2; const bf16_t* Bt2; };

struct StaticOrder {
    int nM, nN, nwg, G, c;
    __host__ __device__ void init(int M, int N, int G_, int c_) { nM = M / BM; nN = N / BM; nwg = nM * nN; G = G_; c = c_; }
    __host__ __device__ bool next(int i, Unit& u) const { const long L = (long)i * G + c; if (L >= nwg) return false; map((int)L, u); return true; }
    __host__ __device__ void map(int L, Unit& u) const {
        int wgid = L; { const int q = nwg / NXCD, r = nwg % NXCD, xcd = wgid % NXCD, off = wgid / NXCD; wgid = (xcd < r ? xcd * (q + 1) : r * (q + 1) + (xcd - r) * q) + off; }
        const int nig = WGM * nN, gid = wgid / nig, fm = gid * WGM, gsz = (nM - fm) < WGM ? (nM - fm) : WGM;
        u.pm = fm + ((wgid % nig) % gsz); u.pn = (wgid % nig) / gsz; u.kind = 0;
    }
};
struct DualOrder {
    StaticOrder s1, s2;
    __device__ __forceinline__ bool next(int i, Unit& u) const {
        const int L = i * s1.G + s1.c;
        if (L < s1.nwg) { s1.map(L, u); return true; }
        if (L - s1.nwg < s2.nwg) { s2.map(L - s1.nwg, u); u.kind = 1; return true; }
        return false;
    }
};

typedef f32x4 Acc[2][2][4][2];

__device__ __forceinline__ u32x4 pack8(const f32x4 v0, const f32x4 v1) {
    u32x4 w; w.x = cvt_pk_bf16(v0[0], v0[1]); w.y = cvt_pk_bf16(v0[2], v0[3]); w.z = cvt_pk_bf16(v1[0], v1[1]); w.w = cvt_pk_bf16(v1[2], v1[3]); return w;
}

struct EpiSwiglu {
    static constexpr bool PERM = true; static constexpr bool HAS_PRE = true;
    bf16_t* H; const float* part;
    __device__ __forceinline__ f32x4 pre_load(const Unit& u, int tid) const { return *(const f32x4*)(part + (size_t)(u.pm * BM + (tid & 255)) * 4); }
    __device__ __forceinline__ void pre_store(const f32x4 a, int tid, LAS float* tab) const { if (tid < 256) tab[tid] = rsqrtf(((a.x + a.y) + (a.z + a.w)) * (1.0f / 1024.0f) + RMS_EPS); }
    __device__ __forceinline__ void operator()(const Acc& acc, const Unit& u, int wr, int wc, int fr, int fq, const LAS float* p) const {
        const int row0 = u.pm * BM + wr * 64 + fr, col0 = u.pn * HALF + wc * 32 + 8 * fq;
#pragma unroll
        for (int ai = 0; ai < 2; ++ai)
#pragma unroll
            for (int m = 0; m < 4; ++m) {
                const int row = row0 + ai * HALF + m * 16; const float rs = p[ai * HALF + wr * 64 + m * 16 + fr];
                f32x4 h[2];
#pragma unroll
                for (int n = 0; n < 2; ++n) {
                    const f32x4 g = acc[ai][0][m][n] * rs, up = acc[ai][1][m][n] * rs;
#pragma unroll
                    for (int j = 0; j < 4; ++j) h[n][j] = g[j] * sigmoidf_(g[j]) * up[j];
                }
                WT16(WT_RSRC(H, NTOK * DFF * 2), (unsigned)(row * DFF + col0) * 2u, pack8(h[0], h[1]));
                if (m & 1) asm volatile("" ::: "memory");
            }
    }
};
template <int ALPHA2, bool FIN> struct EpiResid {
    static constexpr bool PERM = true; static constexpr bool HAS_PRE = false;
    const float* base; float* out; bf16_t* xb; float* part;
    static constexpr float alpha = 0.5f * ALPHA2; static constexpr int fin = FIN ? 1 : 0;
    const float* gfin; unsigned* cnt;
    __device__ __forceinline__ void operator()(Acc& acc, const Unit& u, int wr, int wc, int fr, int fq) const {
        LAS float* P = (LAS float*)(uintptr_t)131072;
        const unsigned off0 = (unsigned)((u.pm * BM + wr * 64 + fr) * DM + u.pn * BM + wc * 32 + 8 * fq);
#pragma unroll
        for (int h4 = 0; h4 < 4; ++h4) {
            const int ai = h4 >> 1, mb = (h4 & 1) * 2;
            f32x4 pre[2][2][2];
#pragma unroll
            for (int mm = 0; mm < 2; ++mm)
#pragma unroll
                for (int bj = 0; bj < 2; ++bj)
#pragma unroll
                    for (int n = 0; n < 2; ++n) pre[mm][bj][n] = *(const f32x4*)(base + off0 + (unsigned)((ai * HALF + (mb + mm) * 16) * DM + bj * HALF + n * 4));
            asm volatile("" ::: "memory");
#pragma unroll
            for (int mm = 0; mm < 2; ++mm) {
                const int m = mb + mm;
                const unsigned off = off0 + (unsigned)((ai * HALF + m * 16) * DM); float ss = 0.f;
#pragma unroll
                for (int bj = 0; bj < 2; ++bj) {
                    const unsigned o2 = off + (unsigned)(bj * HALF);
                    const f32x4 o0 = pre[mm][bj][0] + acc[ai][bj][m][0] * alpha, o1 = pre[mm][bj][1] + acc[ai][bj][m][1] * alpha;
                    ss += ((o0[0] * o0[0] + o0[1] * o0[1]) + (o0[2] * o0[2] + o0[3] * o0[3])) + ((o1[0] * o1[0] + o1[1] * o1[1]) + (o1[2] * o1[2] + o1[3] * o1[3]));
                    if (!fin) { __builtin_nontemporal_store(o0, (f32x4*)(out + o2)); __builtin_nontemporal_store(o1, (f32x4*)(out + o2 + 4)); WT16(WT_RSRC(xb, NTOK * DM * 2), o2 * 2u, pack8(o0, o1)); }
                    else { acc[ai][bj][m][0] = o0; acc[ai][bj][m][1] = o1; }
                }
                ss += sx(ss, 16, fr + 16 * fq); ss += sx(ss, 32, fr + 16 * fq);
                if (fq == 0) P[(ai * HALF + wr * 64 + m * 16 + fr) * 4 + wc] = ss;
            }
            asm volatile("" ::: "memory");
        }
        asm volatile("s_waitcnt lgkmcnt(0)" ::: "memory"); __builtin_amdgcn_s_barrier(); asm volatile("" ::: "memory");
        const int wid = wr * 4 + wc, lane = fq * 16 + fr, t = wid * 64 + lane;
        if (!fin) {
            if (t < 256) { const f32x4 p = *(const LAS f32x4*)(P + t * 4); part[(size_t)(u.pm * BM + t) * 4 + u.pn] = (p.x + p.y) + (p.z + p.w); }
        } else {
            LAS float* S = P + 1024; LAS unsigned* flag = (LAS unsigned*)(P + 1024 + 256);
            unsigned* pc = cnt + 64 * u.pm;
            if (t < 256) { const f32x4 p = *(const LAS f32x4*)(P + t * 4);
                __hip_atomic_store((unsigned*)part + (size_t)(u.pm * BM + t) * 4 + u.pn, __float_as_uint((p.x + p.y) + (p.z + p.w)), __ATOMIC_RELAXED, __HIP_MEMORY_SCOPE_AGENT); }
            asm volatile("s_waitcnt vmcnt(0)" ::: "memory");
            if (wid < 4 && lane == 0) __hip_atomic_fetch_add(pc, 1u, __ATOMIC_RELAXED, __HIP_MEMORY_SCOPE_AGENT);
            if (wid == 0) {
                unsigned spins = 0;
                while ((unsigned)__builtin_amdgcn_readfirstlane(__hip_atomic_load(pc, __ATOMIC_RELAXED, __HIP_MEMORY_SCOPE_AGENT)) < 16u && ++spins < (1u << 22)) __builtin_amdgcn_s_sleep(2);
                __builtin_amdgcn_fence(__ATOMIC_ACQUIRE, "agent");
                if (lane == 0) flag[0] = (spins >= (1u << 22)) ? 1u : 0u;
            }
            asm volatile("s_waitcnt vmcnt(0) lgkmcnt(0)" ::: "memory"); __builtin_amdgcn_s_barrier(); asm volatile("" ::: "memory");
            if (t < 256) {
                unsigned* sl = (unsigned*)part + (size_t)(u.pm * BM + t) * 4;
                const float a0 = __uint_as_float(__hip_atomic_load(sl + 0, __ATOMIC_RELAXED, __HIP_MEMORY_SCOPE_AGENT)), a1 = __uint_as_float(__hip_atomic_load(sl + 1, __ATOMIC_RELAXED, __HIP_MEMORY_SCOPE_AGENT));
                const float a2 = __uint_as_float(__hip_atomic_load(sl + 2, __ATOMIC_RELAXED, __HIP_MEMORY_SCOPE_AGENT)), a3 = __uint_as_float(__hip_atomic_load(sl + 3, __ATOMIC_RELAXED, __HIP_MEMORY_SCOPE_AGENT));
                S[t] = (flag[0] != 0u) ? __builtin_nanf("") : rsqrtf(((a0 + a1) + (a2 + a3)) * (1.0f / 1024.0f) + RMS_EPS);
            }
            asm volatile("s_waitcnt vmcnt(0) lgkmcnt(0)" ::: "memory"); __builtin_amdgcn_s_barrier(); asm volatile("" ::: "memory");
            f32x4 gv[2][2];
#pragma unroll
            for (int bj = 0; bj < 2; ++bj)
#pragma unroll
                for (int n = 0; n < 2; ++n) gv[bj][n] = *(const f32x4*)(gfin + u.pn * BM + wc * 32 + 8 * fq + bj * HALF + 4 * n);
#pragma unroll
            for (int ai = 0; ai < 2; ++ai)
#pragma unroll
                for (int m = 0; m < 4; ++m) {
                    const float rs = S[ai * HALF + wr * 64 + m * 16 + fr];
                    const unsigned off = off0 + (unsigned)((ai * HALF + m * 16) * DM);
#pragma unroll
                    for (int bj = 0; bj < 2; ++bj) {
                        *(f32x4*)(out + off + (unsigned)(bj * HALF)) = acc[ai][bj][m][0] * rs * gv[bj][0];
                        *(f32x4*)(out + off + (unsigned)(bj * HALF) + 4) = acc[ai][bj][m][1] * rs * gv[bj][1];
                    }
                }
        }
        asm volatile("s_waitcnt lgkmcnt(0)" ::: "memory"); __builtin_amdgcn_s_barrier(); asm volatile("" ::: "memory");
    }
};
struct EpiMixIn {
    static constexpr bool PERM = true; static constexpr bool HAS_PRE = false;
    bf16_t* Z; const float* part; const float* gbias;
    __device__ __forceinline__ void operator()(const Acc& acc, const Unit& u, int wr, int wc, int fr, int fq) const {
        const int row0 = u.pm * BM + wr * 64 + fr, col0 = u.pn * BM + wc * 32 + 8 * fq; const bool gate = u.pn >= 4, kt = (u.pn >> 1) == 1;
        f32x4 bv[2][2];
#pragma unroll
        for (int bj = 0; bj < 2; ++bj)
#pragma unroll
            for (int n = 0; n < 2; ++n) bv[bj][n] = gate ? *(const f32x4*)(gbias + (col0 - 1024) + bj * HALF + 4 * n) : (f32x4){0.f, 0.f, 0.f, 0.f};
        float rsv[2][4];
#pragma unroll
        for (int ai = 0; ai < 2; ++ai)
#pragma unroll
            for (int m = 0; m < 4; ++m) rsv[ai][m] = row_rstd(part, row0 + ai * HALF + m * 16);
#pragma unroll
        for (int ai = 0; ai < 2; ++ai)
#pragma unroll
            for (int m = 0; m < 4; ++m) {
                const int row = row0 + ai * HALF + m * 16; const float rs = rsv[ai][m];
#pragma unroll
                for (int bj = 0; bj < 2; ++bj) {
                    f32x4 v[2];
#pragma unroll
                    for (int n = 0; n < 2; ++n) {
                        v[n] = acc[ai][bj][m][n] * rs;
                        if (gate) {
                            v[n] = v[n] + bv[bj][n];
#pragma unroll
                            for (int j = 0; j < 4; ++j) v[n][j] = sigmoidf_(v[n][j]);
                        }
                    }
                    const int col = col0 + bj * HALF;
                    size_t zoff = (size_t)row * ZLD + col;
                    if (kt) {
                        const int hh = (col - 512) >> 6, d0 = (col - 512) & 63;
                        zoff = (size_t)(hh * 2048 + (row >> 3)) * ZLD + 512 + ((((((row >> 2) & 1) * 2 + (d0 >> 5)) * 4 + (row & 3)) * 4 + ((d0 >> 3) & 3)) * 8);
                    }
                    if (gate) __builtin_nontemporal_store(pack8(v[0], v[1]), (u32x4*)(Z + zoff)); else WT16(WT_RSRC(Z, NTOK * ZLD * 2), (unsigned)zoff * 2u, pack8(v[0], v[1]));
                }
                if (m & 1) asm volatile("" ::: "memory");
            }
    }
};
struct EpiColScale {
    static constexpr bool PERM = true; static constexpr bool HAS_PRE = false;
    bf16_t* O; int ldc; const float* part;
    __device__ __forceinline__ void operator()(const Acc& acc, const Unit& u, int wr, int wc, int fr, int fq) const {
        const int row0 = u.pm * BM + wr * 64 + fr, col0 = u.pn * BM + wc * 32 + 8 * fq;
        f32x4 cs[2][2];
#pragma unroll
        for (int bj = 0; bj < 2; ++bj)
#pragma unroll
            for (int n = 0; n < 2; ++n)
#pragma unroll
                for (int j = 0; j < 4; ++j) cs[bj][n][j] = row_rstd(part, col0 + bj * HALF + 4 * n + j);
#pragma unroll
        for (int ai = 0; ai < 2; ++ai)
#pragma unroll
            for (int m = 0; m < 4; ++m) {
                const int row = row0 + ai * HALF + m * 16;
#pragma unroll
                for (int bj = 0; bj < 2; ++bj)
                {
                    const int col = col0 + bj * HALF;
                    size_t ooff = (size_t)row * ldc + col;
                    if (u.pm < 2) ooff = ((size_t)(((row >> 6) * 2048 + (col >> 3)) * 4 + ((row >> 4) & 3))) * 128 + (row & 15) * 8;
                    WT16(WT_RSRC(O, 1024 * NTOK * 2), (unsigned)ooff * 2u, pack8(acc[ai][bj][m][0] * cs[bj][0], acc[ai][bj][m][1] * cs[bj][1]));
                }
            }
    }
};
struct EpiInDual {
    static constexpr bool PERM = true; static constexpr bool HAS_PRE = false;
    EpiMixIn e0; EpiColScale e1;
    __device__ __forceinline__ void operator()(const Acc& acc, const Unit& u, int wr, int wc, int fr, int fq) const { if (u.kind == 0) e0(acc, u, wr, wc, fr, fq); else e1(acc, u, wr, wc, fr, fq); }
};
template <bool ADD> struct EpiGate {
    static constexpr bool PERM = true; static constexpr bool HAS_PRE = false;
    const bf16_t* G; bf16_t* Mb;
    __device__ __forceinline__ void operator()(const Acc& acc, const Unit& u, int wr, int wc, int fr, int fq) const {
        const int row0 = u.pm * BM + wr * 64 + fr, col0 = u.pn * BM + wc * 32 + 8 * fq;
#pragma unroll
        for (int ai = 0; ai < 2; ++ai) {
            u32x4 gw[4][2], pw[4][2];
#pragma unroll
            for (int m = 0; m < 4; ++m)
#pragma unroll
                for (int bj = 0; bj < 2; ++bj) {
                    const int row = row0 + ai * HALF + m * 16;
                    gw[m][bj] = *(const u32x4*)(G + (size_t)row * ZLD + col0 + bj * HALF);
                    if (ADD) pw[m][bj] = *(const u32x4*)(Mb + (size_t)row * DM + col0 + bj * HALF);
                }
            asm volatile("" ::: "memory");
#pragma unroll
            for (int m = 0; m < 4; ++m)
#pragma unroll
                for (int bj = 0; bj < 2; ++bj) {
                    const int row = row0 + ai * HALF + m * 16;
                    bf16_t* mp = Mb + (size_t)row * DM + col0 + bj * HALF;
                    const u32x4 g4 = gw[m][bj];
                    f32x4 v0 = acc[ai][bj][m][0], v1 = acc[ai][bj][m][1];
                    v0[0] *= bf_lo(g4.x); v0[1] *= bf_hi(g4.x); v0[2] *= bf_lo(g4.y); v0[3] *= bf_hi(g4.y);
                    v1[0] *= bf_lo(g4.z); v1[1] *= bf_hi(g4.z); v1[2] *= bf_lo(g4.w); v1[3] *= bf_hi(g4.w);
                    if (ADD) {
                        const u32x4 p4 = pw[m][bj];
                        v0[0] += bf_lo(p4.x); v0[1] += bf_hi(p4.x); v0[2] += bf_lo(p4.y); v0[3] += bf_hi(p4.y);
                        v1[0] += bf_lo(p4.z); v1[1] += bf_hi(p4.z); v1[2] += bf_lo(p4.w); v1[3] += bf_hi(p4.w);
                    }
                    WT16(WT_RSRC(Mb, NTOK * DM * 2), (unsigned)(row * DM + col0 + bj * HALF) * 2u, pack8(v0, v1));
                }
            asm volatile("" ::: "memory");
        }
    }
};
struct EpiDftA {
    static constexpr bool PERM = true; static constexpr bool HAS_PRE = false;
    bf16_t* Ap; const f32x2* tab; float scale;
    __device__ __forceinline__ void operator()(const Acc& acc, const Unit& u, int wr, int wc, int fr, int fq) const {
        const int nb = u.pn * BM + wc * 32 + 8 * fq, t2 = nb & 63;
#pragma unroll
        for (int m = 0; m < 4; ++m) {
            const int k1 = wr * 64 + m * 16 + fr;
            f32x2 cs[8];
            cs[0] = tab[(unsigned)(k1 * t2)]; const f32x2 w = tab[(unsigned)k1];
            cs[0].x *= scale; cs[0].y *= scale;
#pragma unroll
            for (int e = 1; e < 8; ++e) { cs[e].x = cs[e - 1].x * w.x - cs[e - 1].y * w.y; cs[e].y = cs[e - 1].y * w.x + cs[e - 1].x * w.y; }
#pragma unroll
            for (int bj = 0; bj < 2; ++bj) {
                const int n0 = nb + bj * HALF, ch = (n0 >> 6) & 511, b = n0 >> 15;
                const unsigned doff = (unsigned)(((b * 64 + (k1 & 63)) * 512 + ch) * 256 + (k1 >> 6) * 128 + t2);
                f32x4 re[2], im[2];
#pragma unroll
                for (int n = 0; n < 2; ++n)
#pragma unroll
                    for (int j = 0; j < 4; ++j) {
                        const float ar = acc[0][bj][m][n][j], ai_ = acc[1][bj][m][n][j]; const f32x2 c = cs[4 * n + j];
                        re[n][j] = ar * c.x + ai_ * c.y; im[n][j] = ai_ * c.x - ar * c.y;
                    }
                WT16(WT_RSRC(Ap, 65536 * 256 * 2), doff * 2u, pack8(re[0], re[1]));
                WT16(WT_RSRC(Ap, 65536 * 256 * 2), (doff + 64u) * 2u, pack8(im[0], im[1]));
            }
            asm volatile("" ::: "memory");
        }
    }
};
struct EpiDftB {
    static constexpr bool PERM = true; static constexpr bool HAS_PRE = false;
    bf16_t* FW; float scale;
    __device__ __forceinline__ void operator()(const Acc& acc, const Unit& u, int wr, int wc, int fr, int fq) const {
        const int nb = u.pn * BM + wc * 32 + 8 * fq;
#pragma unroll
        for (int bj = 0; bj < 2; ++bj) {
            const int n0 = nb + bj * HALF, ch = n0 & 511, k1lo = (n0 >> 9) & 63, b = n0 >> 15;
            const unsigned base = (unsigned)((b * SEQ + k1lo + 64 * wr + 128 * fr) * DM + ch);
#pragma unroll
            for (int ai = 0; ai < 2; ++ai)
#pragma unroll
                for (int m = 0; m < 4; ++m) {
                    WT16(WT_RSRC(FW, NTOK * DM * 2), (base + (unsigned)(128 * 16 * m * DM + ai * 512)) * 2u, pack8(acc[ai][bj][m][0] * scale, acc[ai][bj][m][1] * scale));
                    if (m & 1) asm volatile("" ::: "memory");
                }
        }
    }
};

struct OneUnit { int pn; __device__ __forceinline__ bool next(int i, Unit& u) const { if (i) return false; u.pm = 0; u.pn = pn; u.kind = 0; return true; } };
template <class Epi, class Sched = StaticOrder>
__device__ __forceinline__ void gemm_phase(LAS unsigned char* lds, const Gemm g, const Sched& S, const Epi& E, const int wave_) {
    int tid = wave_ * 64 + (int)lane_id_fresh(); asm volatile("" : "+v"(tid));
    const int wid = __builtin_amdgcn_readfirstlane(tid >> 6), lane = tid & 63, wr = wid >> 2, wc = wid & 3, fr = lane & 15, fq = lane >> 4;
    int K = g.K;
    asm volatile("" : "+s"(K));
    const int nt = K / BK;
    unsigned voffA[2], voffB[2];
#pragma unroll
    for (int i = 0; i < 2; ++i) { int R, C; stage_rc(tid * 16 + i * 8192, R, C); const int Rb = Epi::PERM ? ((R & ~31) + perm32(R & 31)) : R;
        voffA[i] = (unsigned)(R * g.lda + C) * 2u; voffB[i] = (unsigned)(Rb * g.ldb + C) * 2u; }
    const size_t kstep = (size_t)(BK * 2);
    const size_t hstepA = (size_t)HALF * g.lda * 2, hstepB = (size_t)HALF * g.ldb * 2;
    const size_t tstepA = 2 * hstepA, tstepB = 2 * hstepB;
    const unsigned ldsw = (unsigned)wid * 1024u;
    const int aoff = lds_byte(wr * 64 + fr, fq * 8), boff = lds_byte(wc * 32 + fr, fq * 8);
#define PG8_SA(b, h) (((b) * 2 + (h)) * HTB)
#define PG8_SB(b, h) ((4 + (b) * 2 + (h)) * HTB)
#define PG8_STAGE(bufoff, gbase, voff) do { _Pragma("unroll") for (int _i = 0; _i < 2; ++_i) \
        __builtin_amdgcn_global_load_lds((const unsigned*)((const char*)(gbase) + (voff)[_i]), (LAS unsigned*)(lds + (bufoff) + ldsw + _i * 8192), 16, 0, 0); } while (0)
#define PG8_LDA(dst, b, h) do { _Pragma("unroll") for (int m = 0; m < 4; ++m) _Pragma("unroll") for (int k = 0; k < 2; ++k) dst[m][k] = *(const LAS bf16x8*)(lds + PG8_SA(b, h) + aoff + m * 2048 + k * 1024); } while (0)
#define PG8_LDB(dst, b, h) do { _Pragma("unroll") for (int n = 0; n < 2; ++n) _Pragma("unroll") for (int k = 0; k < 2; ++k) dst[n][k] = *(const LAS bf16x8*)(lds + PG8_SB(b, h) + boff + n * 2048 + k * 1024); } while (0)
#define PG8_MMA(ai, bj, At, Bt) do { __builtin_amdgcn_s_setprio(1); _Pragma("unroll") for (int m = 0; m < 4; ++m) _Pragma("unroll") for (int n = 0; n < 2; ++n) _Pragma("unroll") for (int k = 0; k < 2; ++k) \
        acc[ai][bj][m][n] = __builtin_amdgcn_mfma_f32_16x16x32_bf16(Bt[n][k], At[m][k], acc[ai][bj][m][n], 0, 0, 0); __builtin_amdgcn_s_setprio(0); } while (0)
#define PG8_WAIT_V(n) asm volatile("s_waitcnt vmcnt(" #n ")" ::: "memory")
#define PG8_WAIT_L(n) asm volatile("s_waitcnt lgkmcnt(" #n ")" ::: "memory")
#define PG8_BAR __builtin_amdgcn_s_barrier()
#define PG8_SCHED __builtin_amdgcn_sched_barrier(0)
    Unit cur, nxt; int ui = 0;
    if (!S.next(0, cur)) return;
    LAS float* ptab = (LAS float*)(uintptr_t)(131072 + 8192);
    if constexpr (Epi::HAS_PRE) { E.pre_store(E.pre_load(cur, tid), tid, ptab); asm volatile("s_waitcnt lgkmcnt(0)" ::: "memory"); __builtin_amdgcn_s_barrier(); }
    Acc acc;
#pragma unroll
    for (int a = 0; a < 2; ++a)
#pragma unroll
        for (int b = 0; b < 2; ++b)
#pragma unroll
            for (int m = 0; m < 4; ++m)
#pragma unroll
                for (int n = 0; n < 2; ++n) acc[a][b][m][n] = (f32x4){0.f, 0.f, 0.f, 0.f};
    bf16x8 At[4][2], B0[2][2], B1[2][2];
    const char* cA = (const char*)(cur.kind ? g.A2 : g.A) + (size_t)cur.pm * tstepA; const char* cB = (const char*)(cur.kind ? g.Bt2 : g.Bt) + (size_t)cur.pn * tstepB;
    PG8_STAGE(PG8_SB(0, 0), cB, voffB); PG8_STAGE(PG8_SB(0, 1), cB + hstepB, voffB); PG8_STAGE(PG8_SA(0, 0), cA, voffA); PG8_STAGE(PG8_SA(0, 1), cA + hstepA, voffA);
    if (wr == 1) PG8_BAR;
    PG8_WAIT_V(2); PG8_BAR;
    PG8_STAGE(PG8_SB(1, 0), cB + kstep, voffB); PG8_STAGE(PG8_SA(1, 0), cA + kstep, voffA); PG8_STAGE(PG8_SB(1, 1), cB + hstepB + kstep, voffB);
    PG8_WAIT_V(6); PG8_BAR;
    for (;;) {
        const bool has_next = S.next(ui + 1, nxt);
        const char* nA = has_next ? (const char*)(nxt.kind ? g.A2 : g.A) + (size_t)nxt.pm * tstepA : cA; const char* nB = has_next ? (const char*)(nxt.kind ? g.Bt2 : g.Bt) + (size_t)nxt.pn * tstepB : cB;
        for (int t = 0; t < nt; t += 2) {
            const bool last = (t == nt - 2);
            const char* a1 = cA + (size_t)(t + 1) * kstep;
            const char* a2 = last ? nA : cA + (size_t)(t + 2) * kstep; const char* b2 = last ? nB : cB + (size_t)(t + 2) * kstep;
            const char* a3 = a2 + kstep; const char* b3 = b2 + kstep;
            PG8_LDB(B0, 0, 0); PG8_LDB(B1, 0, 1); PG8_SCHED; PG8_LDA(At, 0, 0); PG8_STAGE(PG8_SA(1, 1), a1 + hstepA, voffA);
            PG8_WAIT_V(8); PG8_WAIT_L(0); PG8_BAR; PG8_MMA(0, 0, At, B0); PG8_MMA(0, 1, At, B1); PG8_BAR; PG8_SCHED;
            PG8_LDA(At, 0, 1); PG8_STAGE(PG8_SB(0, 0), b2, voffB); PG8_STAGE(PG8_SB(0, 1), b2 + hstepB, voffB); PG8_STAGE(PG8_SA(0, 0), a2, voffA);
            PG8_WAIT_V(8); PG8_WAIT_L(0); PG8_BAR; PG8_MMA(1, 0, At, B0); PG8_MMA(1, 1, At, B1); PG8_BAR; PG8_SCHED;
            PG8_LDB(B0, 1, 0); PG8_LDB(B1, 1, 1); PG8_SCHED; PG8_LDA(At, 1, 0); PG8_STAGE(PG8_SA(0, 1), a2 + hstepA, voffA);
            PG8_WAIT_V(8); PG8_WAIT_L(0); PG8_BAR; PG8_MMA(0, 0, At, B0); PG8_MMA(0, 1, At, B1); PG8_BAR; PG8_SCHED;
            PG8_LDA(At, 1, 1); PG8_STAGE(PG8_SB(1, 0), b3, voffB); PG8_STAGE(PG8_SB(1, 1), b3 + hstepB, voffB); PG8_STAGE(PG8_SA(1, 0), a3, voffA);
            PG8_WAIT_V(8); PG8_WAIT_L(0); PG8_BAR; PG8_MMA(1, 0, At, B0); PG8_MMA(1, 1, At, B1); PG8_BAR; PG8_SCHED;
        }
        if (wr == 0) PG8_BAR;
        if constexpr (Epi::HAS_PRE) {
            f32x4 raw = (f32x4){0.f, 0.f, 0.f, 0.f};
            if (has_next) raw = E.pre_load(nxt, tid);
            E(acc, cur, wr, wc, fr, fq, ptab + (ui & 1) * 256);
            if (has_next) E.pre_store(raw, tid, ptab + ((ui + 1) & 1) * 256);
        } else E(acc, cur, wr, wc, fr, fq);
        if (!has_next) break;
#pragma unroll
        for (int a = 0; a < 2; ++a)
#pragma unroll
            for (int b = 0; b < 2; ++b)
#pragma unroll
                for (int m = 0; m < 4; ++m)
#pragma unroll
                    for (int n = 0; n < 2; ++n) acc[a][b][m][n] = (f32x4){0.f, 0.f, 0.f, 0.f};
        cur = nxt; cA = nA; cB = nB; ++ui;
        if (wr == 1) PG8_BAR;
    }
    PG8_WAIT_V(0);
    PG8_BAR;
#undef PG8_SA
#undef PG8_SB
#undef PG8_STAGE
#undef PG8_LDA
#undef PG8_LDB
#undef PG8_MMA
#undef PG8_WAIT_V
#undef PG8_WAIT_L
#undef PG8_BAR
#undef PG8_SCHED
}
}

__device__ __forceinline__ unsigned f2bf(float f) { unsigned u = __builtin_bit_cast(unsigned, f); return (u + 0x7fffu + ((u >> 16) & 1u)) >> 16; }
__device__ __forceinline__ unsigned pk2(float lo, float hi) { return f2bf(lo) | (f2bf(hi) << 16); }
__device__ __forceinline__ int destrow(int mode, int n) {
    if (mode == 1) { const int isu = n >= DFF ? 1 : 0; const int h = n - DFF * isu; return ((h >> 7) << 8) + (isu << 7) + (h & 127); }
    if (mode == 2) return n < 1024 ? n : (n < 2048 ? n + 2048 : n - 1024);
    return n;
}
__device__ __forceinline__ void tr_item(const float* W, int K, int N, bf16_t* WT, int mode, const float* gain, LAS float* scr, int item, int lane) {
    const int nblk = N / 64, kb = item / nblk, nb = item % nblk, k0 = 64 * kb, n0 = 64 * nb;
    const int ln = (lane & 15) * 4, lk = lane >> 4;
#pragma unroll
    for (int i = 0; i < 16; ++i) { const int kk = 4 * i + lk; const f32x4 w = *(const f32x4*)(W + (size_t)(k0 + kk) * N + n0 + ln);
        LAS float* d = scr + kk * 65 + ln; d[0] = w.x; d[1] = w.y; d[2] = w.z; d[3] = w.w; }
    const int c = lane & 7;
    f32x4 g0 = (f32x4){1.f, 1.f, 1.f, 1.f}, g1 = g0;
    if (gain) { g0 = *(const f32x4*)(gain + k0 + 8 * c); g1 = *(const f32x4*)(gain + k0 + 8 * c + 4); }
    LDS_WAIT();
#pragma unroll
    for (int j = 0; j < 8; ++j) { const int n = (lane >> 3) + 8 * j; const LAS float* s = scr + (8 * c) * 65 + n;
        u32x4 o; o.x = pk2(s[0 * 65] * g0.x, s[1 * 65] * g0.y); o.y = pk2(s[2 * 65] * g0.z, s[3 * 65] * g0.w); o.z = pk2(s[4 * 65] * g1.x, s[5 * 65] * g1.y); o.w = pk2(s[6 * 65] * g1.z, s[7 * 65] * g1.w);
        *(u32x4*)(WT + (size_t)destrow(mode, n0 + n) * K + k0 + 8 * c) = o; }
    LDS_WAIT();
}

#define RLX_AGENT __ATOMIC_RELAXED, __HIP_MEMORY_SCOPE_AGENT
#define XB_TMO      128
#define XB_XCNT(j)  (256  + 64 * (j))
#define XB_XSUB(j)  (1280 + 64 * (j))
#define XB_XGEN(j)  (2304 + 64 * (j))
#define XB_TOP      3328
#define XB_TOPGEN   3392
#define XCD_BAR_WORDS 3456
#define XB_SPIN_CAP (1u << 18)

__device__ __forceinline__ unsigned xb_ld(unsigned* p)              { return __hip_atomic_load(p, __ATOMIC_RELAXED, __HIP_MEMORY_SCOPE_AGENT); }
__device__ __forceinline__ unsigned xb_add(unsigned* p, unsigned v) { return __hip_atomic_fetch_add(p, v, __ATOMIC_RELAXED, __HIP_MEMORY_SCOPE_AGENT); }
__device__ __forceinline__ unsigned xb_xcc_id() { return (unsigned)__builtin_amdgcn_s_getreg((3 << 11) | 20) & 0xFu; }
#define XB_SPIN(cond, bar) do { unsigned _sp = 0; while (cond) { __builtin_amdgcn_s_sleep(1); \
    if ((++_sp & 255u) == 0u) { if (xb_ld(&(bar)[XB_TMO])) break; if (_sp > XB_SPIN_CAP) { atomicAdd(&(bar)[XB_TMO], 1u); break; } } } } while (0)

struct XcdBarrier {
    unsigned* bar; unsigned x;
    volatile LAS unsigned* st;
};

__device__ __forceinline__ XcdBarrier xcd_barrier_post(unsigned* bar, volatile LAS unsigned* st) {
    XcdBarrier b; b.bar = bar; b.x = xb_xcc_id(); b.st = st;
    if (threadIdx.x == 0) (void)xb_add(&bar[XB_XCNT(b.x)], 1u);
    return b;
}
__device__ __forceinline__ void xcd_barrier_complete(unsigned* bar, unsigned x, unsigned& nloc, unsigned& nx) {
    const unsigned G = gridDim.x * gridDim.y * gridDim.z;
    unsigned sum, cnt, mine, sp = 0u;
    for (;;) {
        sum = 0u; cnt = 0u; mine = 0u;
#pragma unroll
        for (unsigned j = 0; j < 16; ++j) { const unsigned c = xb_ld(&bar[XB_XCNT(j)]); sum += c; cnt += (c > 0u) ? 1u : 0u; mine = (j == x) ? c : mine; }
        if (sum == G) break;
        __builtin_amdgcn_s_sleep(1);
        if ((++sp & 255u) == 0u) { if (xb_ld(&bar[XB_TMO])) break; if (sp > XB_SPIN_CAP) { atomicAdd(&bar[XB_TMO], 1u); break; } }
    }
    nloc = mine > 0u ? mine : 1u; nx = cnt > 0u ? cnt : 1u;
}

__device__ __forceinline__ void xcd_barrier(const XcdBarrier& b, const int wave_) {
    asm volatile("s_waitcnt vmcnt(0)" ::: "memory");
    __syncthreads();
    if (wave_ == 0 && lane_id_fresh() == 0u) {
        unsigned* bar = b.bar;
        __builtin_amdgcn_s_waitcnt(0);
        unsigned nloc = b.st[0], nx = b.st[1];
        if (nloc == 0u) { xcd_barrier_complete(bar, b.x, nloc, nx); b.st[0] = nloc; b.st[1] = nx; }
        const unsigned old = xb_add(&bar[XB_XSUB(b.x)], 1u);
        const unsigned gen = old / nloc;
        if (old + 1u == (gen + 1u) * nloc) {
            __builtin_amdgcn_fence(__ATOMIC_RELEASE, "agent");
            asm volatile("s_waitcnt vmcnt(0)" ::: "memory");
            const unsigned og = xb_add(&bar[XB_TOP], 1u);
            const unsigned tg = og / nx;
            if (og + 1u == (tg + 1u) * nx) xb_add(&bar[XB_TOPGEN], 1u);
            else XB_SPIN(xb_ld(&bar[XB_TOPGEN]) == tg, bar);
            __builtin_amdgcn_fence(__ATOMIC_ACQUIRE, "agent");
            xb_add(&bar[XB_XGEN(b.x)], 1u);
            asm volatile("s_waitcnt vmcnt(0)" ::: "memory");
        } else {
            XB_SPIN(xb_ld(&bar[XB_XGEN(b.x)]) == gen, bar);
            __builtin_amdgcn_fence(__ATOMIC_ACQUIRE, "agent");
            asm volatile("s_waitcnt vmcnt(0)" ::: "memory");
        }
    }
    __syncthreads();
}


struct Args { const float* in[15]; float* out; unsigned char* ws; };
typedef const __attribute__((address_space(4))) Args* KArgs;

struct TrDesc { const float* W; bf16_t* WT; const float* gain; int K, N, mode, r; };
__device__ __forceinline__ int tr_count(int sel) {
    return ((sel & 1) ? 1408 : 0) + ((sel & 2) ? 1408 : 0) + ((sel & 4) ? 704 : 0) + ((sel & 8) ? 704 : 0) + ((sel & 16) ? 1024 : 0) + ((sel & 32) ? 128 : 0) + ((sel & 64) ? 256 : 0);
}
__device__ __forceinline__ TrDesc tr_desc(KArgs ap, unsigned char* ws, int l, int sel, int item) {
    const int C0 = (sel & 1) ? 1408 : 0, C1 = (sel & 2) ? 1408 : 0, C2 = (sel & 4) ? 704 : 0, C3 = (sel & 8) ? 704 : 0, C4 = (sel & 16) ? 1024 : 0, C5 = (sel & 32) ? 128 : 0;
    TrDesc d; int r = item;
    if (r < C0) { d.W = ap->in[2] + (size_t)l * DM * 2 * DFF; d.WT = (bf16_t*)(ws + WS_W1A); d.gain = ap->in[1] + l * DM; d.K = DM; d.N = 2 * DFF; d.mode = 1; d.r = r; return d; } r -= C0;
    if (r < C1) { d.W = ap->in[12] + (size_t)l * DM * 2 * DFF; d.WT = (bf16_t*)(ws + WS_W1B); d.gain = ap->in[11] + l * DM; d.K = DM; d.N = 2 * DFF; d.mode = 1; d.r = r; return d; } r -= C1;
    if (r < C2) { d.W = ap->in[3] + (size_t)l * DFF * DM; d.WT = (bf16_t*)(ws + WS_W2A); d.gain = nullptr; d.K = DFF; d.N = DM; d.mode = 0; d.r = r; return d; } r -= C2;
    if (r < C3) { d.W = ap->in[13] + (size_t)l * DFF * DM; d.WT = (bf16_t*)(ws + WS_W2B); d.gain = nullptr; d.K = DFF; d.N = DM; d.mode = 0; d.r = r; return d; } r -= C3;
    if (r < C4) { d.W = ap->in[5] + (size_t)l * DM * 4096; d.WT = (bf16_t*)(ws + WS_WIN); d.gain = ap->in[4] + l * DM; d.K = DM; d.N = 4096; d.mode = 2; d.r = r; return d; } r -= C4;
    if (r < C5) { d.W = ap->in[8] + (size_t)l * 512 * DM; d.WT = (bf16_t*)(ws + WS_WNA); d.gain = nullptr; d.K = 512; d.N = DM; d.mode = 0; d.r = r; return d; } r -= C5;
    d.W = ap->in[10] + (size_t)l * DM * DM; d.WT = (bf16_t*)(ws + WS_WO); d.gain = nullptr; d.K = DM; d.N = DM; d.mode = 0; d.r = r; return d;
}
__device__ __forceinline__ void tr_load(const TrDesc& d, f32x4 (&w)[16], int lane) {
    const int nblk = d.N / 64, kb = d.r / nblk, nb = d.r % nblk, k0 = 64 * kb, n0 = 64 * nb;
    const unsigned loff = (unsigned)((lane >> 4) * d.N + (lane & 15) * 4);
    const float* wb = d.W + (size_t)k0 * d.N + n0;
#pragma unroll
    for (int i = 0; i < 16; ++i) w[i] = __builtin_nontemporal_load((const f32x4*)(wb + (size_t)(4 * i) * d.N + loff));
}
__device__ __forceinline__ void tr_store(const TrDesc& d, const f32x4 (&w)[16], LAS float* scr, int lane) {
    const int nblk = d.N / 64, kb = d.r / nblk, nb = d.r % nblk, k0 = 64 * kb, n0 = 64 * nb, ln = (lane & 15) * 4, lk = lane >> 4;
#pragma unroll
    for (int i = 0; i < 16; ++i) { LAS float* p = scr + (4 * i + lk) * 65 + ln; p[0] = w[i].x; p[1] = w[i].y; p[2] = w[i].z; p[3] = w[i].w; }
    const int c = lane & 7;
    f32x4 g0 = (f32x4){1.f, 1.f, 1.f, 1.f}, g1 = g0;
    if (d.gain) { g0 = *(const f32x4*)(d.gain + k0 + 8 * c); g1 = *(const f32x4*)(d.gain + k0 + 8 * c + 4); }
    LDS_WAIT();
#pragma unroll
    for (int j = 0; j < 8; ++j) { const int n = (lane >> 3) + 8 * j; const LAS float* s = scr + (8 * c) * 65 + n;
        u32x4 o; o.x = pk2(s[0 * 65] * g0.x, s[1 * 65] * g0.y); o.y = pk2(s[2 * 65] * g0.z, s[3 * 65] * g0.w); o.z = pk2(s[4 * 65] * g1.x, s[5 * 65] * g1.y); o.w = pk2(s[6 * 65] * g1.z, s[7 * 65] * g1.w);
        *(u32x4*)(d.WT + (size_t)destrow(d.mode, n0 + n) * d.K + k0 + 8 * c) = o; }
    LDS_WAIT();
}
__device__ __forceinline__ void conv_job(KArgs ap, unsigned char* ws, int l, int sel, int gwl, int ngw, LAS float* scr, int lane) {
    const int nit = tr_count(sel);
    for (int item = gwl; item < nit; item += ngw) { const TrDesc d = tr_desc(ap, ws, l, sel, item); f32x4 wa[16]; tr_load(d, wa, lane); tr_store(d, wa, scr, lane); }
}
__device__ __forceinline__ void g_job(const float* wf, bf16_t* Gt, LAS unsigned char* lds, int tid, int lane, int wave, int bxl, int nblk) {
    LAS float* tg = (LAS float*)lds; LAS float* strip = (LAS float*)(lds + 4096);
    __syncthreads();
    if (tid < 128) { tg[tid] = cospif((float)tid * (1.0f / 64.0f)); tg[128 + tid] = sinpif((float)tid * (1.0f / 64.0f)); }
    for (int bi = bxl; bi < 256; bi += nblk) {
        const int nc = bi & 15, g = (bi >> 4) & 3, combo = (bi >> 6) * 8 + wave, ri = combo >> 4, c0 = (combo & 15) * 8, n = nc * 64 + lane;
        __syncthreads();
#pragma unroll
        for (int i = 0; i < 4; ++i) { const int idx = tid + 512 * i, m = idx >> 4, n4 = (idx & 15) * 4;
            *(LAS f32x4*)(strip + m * 64 + n4) = *(const f32x4*)(wf + (size_t)(g * 128 + m) * DM + nc * 64 + n4); }
        __syncthreads();
        const LAS float* tp = tg + ri * 128;
        float acc8[8];
#pragma unroll
        for (int e = 0; e < 8; ++e) acc8[e] = 0.f;
#pragma unroll 8
        for (int m = 0; m < 128; ++m) { const float w = strip[m * 64 + lane];
#pragma unroll
            for (int e = 0; e < 8; ++e) acc8[e] += tp[((c0 + e) * m) & 127] * w; }
        const float sg = 0.08838834764831845f;
        u32x4 o; o.x = pk2(acc8[0] * sg, acc8[1] * sg); o.y = pk2(acc8[2] * sg, acc8[3] * sg); o.z = pk2(acc8[4] * sg, acc8[5] * sg); o.w = pk2(acc8[6] * sg, acc8[7] * sg);
        *(u32x4*)(Gt + (size_t)n * 1024 + ri * 512 + g * 128 + c0) = o;
    }
    __syncthreads();
}

__global__ void __launch_bounds__(512, 2) fwd_kernel(Args a) {
    extern __shared__ __attribute__((aligned(16))) unsigned char lds_raw[];
    LAS unsigned char* lds = (LAS unsigned char*)lds_raw;
    cg::grid_group grid = cg::this_grid();
    const int wave = __builtin_amdgcn_readfirstlane(threadIdx.x >> 6);
#define LAUNDER_TID() int tid = wave * 64 + (int)lane_id_fresh(); asm volatile("" : "+v"(tid)); const int lane = tid & 63
    constexpr int G = 256;
    const int bx0 = blockIdx.x;
    constexpr int NGW = G * 8;
#define PTRS() \
    KArgs ap = (KArgs)__builtin_amdgcn_kernarg_segment_ptr(); asm volatile("" : "+s"(ap)); \
    int bx_l = bx0; asm volatile("" : "+s"(bx_l)); const int bx = bx_l; const int gw = bx * 8 + wave; \
    unsigned char* ws = ap->ws; \
    const float* x_in = ap->in[0]; \
    float* R = ap->out; \
    f32x2* tab = (f32x2*)(ws + WS_TAB); \
    bf16_t* Dt = (bf16_t*)(ws + WS_DT); bf16_t* Eb = (bf16_t*)(ws + WS_EB); \
    float* part = (float*)(ws + WS_PART); \
    bf16_t* W1tA = (bf16_t*)(ws + WS_W1A); bf16_t* W1tB = (bf16_t*)(ws + WS_W1B); \
    bf16_t* W2tA = (bf16_t*)(ws + WS_W2A); bf16_t* W2tB = (bf16_t*)(ws + WS_W2B); \
    bf16_t* Wint = (bf16_t*)(ws + WS_WIN); bf16_t* Wna_t = (bf16_t*)(ws + WS_WNA); bf16_t* Gt = (bf16_t*)(ws + WS_GT); bf16_t* Wo_t = (bf16_t*)(ws + WS_WO); \
    bf16_t* xb = (bf16_t*)(ws + WS_XB); bf16_t* Z = (bf16_t*)(ws + WS_Z); bf16_t* H = (bf16_t*)(ws + WS_H); \
    bf16_t* VU = (bf16_t*)(ws + WS_VU); bf16_t* Ap = xb; bf16_t* Mb = VU; \
    bf16_t* Xa = (bf16_t*)(ws + WS_XA); bf16_t* FW = Xa;
    {
        unsigned* bw = (unsigned*)a.ws;
        if (bx0 == 0) for (int i = threadIdx.x; i < 8192; i += 512) __hip_atomic_store(bw + i, 0u, RLX_AGENT);
        volatile LAS unsigned* misc = (volatile LAS unsigned*)(lds + MISC_OFF);
        if (threadIdx.x < 32) misc[threadIdx.x] = 0u;
        __threadfence();
        grid.sync();
    }
    XcdBarrier xbar = xcd_barrier_post((unsigned*)a.ws, (volatile LAS unsigned*)(lds + MISC_OFF) + 8);
#define GRID_SYNC() xcd_barrier(xbar, wave)

    for (int it = 0; it < 4; ++it) {
        const int l = it >> 1, which = it & 1;
        if (it == 0) {
            for (int rep = 0; rep < 1 + ((PROBE_DUP >> 0) & 1); ++rep) {
            if constexpr ((PHMASK >> 9) & 1) {
                LAUNDER_TID(); PTRS();
                conv_job(ap, ws, 0, 1, gw, NGW, (LAS float*)(lds + wave * 16640), lane);
                g_job(ap->in[9], Gt, lds, tid, lane, wave, bx, 256);
                __syncthreads();
                if (l == 0) {
                    for (int p = bx * 512 + tid; p < 8192; p += G * 512) { const float ang = (float)p * (1.0f / 4096.0f); tab[p] = (f32x2){cospif(ang), sinpif(ang)}; }
                    for (int i = bx * 512 + tid; i < 256 * 128; i += G * 512) {
                        const int row = i >> 7, t1 = i & 127, ri = row >> 7, k1 = row & 127; const float ang = (float)((k1 * t1) & 127) * (1.0f / 64.0f);
                        Dt[i] = (bf16_t)f2bf(ri == 0 ? cospif(ang) : -sinpif(ang));
                    }
                    for (int i = bx * 512 + tid; i < 256 * 256; i += G * 512) {
                        const int row = i >> 8, kap = i & 255, rio = row >> 7, p = (row >> 6) & 1, k2 = row & 63, pp = kap >> 7, rii = (kap >> 6) & 1, t2 = kap & 63;
                        const float ang = (float)((k2 * t2) & 63) * (1.0f / 32.0f); const float cv = cospif(ang), sv = sinpif(ang);
                        float v = 0.f; if (p == pp) v = (rio == 0) ? (rii == 0 ? cv : sv) : (rii == 0 ? -sv : cv);
                        Eb[i] = (bf16_t)f2bf(v);
                    }
                    for (int row = gw; row < NTOK; row += NGW) {
                        const f32x4* xr = (const f32x4*)(x_in + (size_t)row * DM) + lane; float s = 0.f;
                        unsigned long long* o8 = (unsigned long long*)(xb + (size_t)row * DM) + lane;
#pragma unroll
                        for (int j = 0; j < 4; ++j) { const f32x4 v = xr[64 * j]; s += (v.x * v.x + v.y * v.y) + (v.z * v.z + v.w * v.w);
                            o8[64 * j] = (unsigned long long)pk2(v.x, v.y) | ((unsigned long long)pk2(v.z, v.w) << 32); }
                        s = wave_sum(s, lane);
                        if (lane < 4) part[(size_t)row * 4 + lane] = lane == 0 ? s : 0.f;
                    }
                }
            }
            GRID_SYNC(); }
        }
            for (int rep = 0; rep < 1 + ((PROBE_DUP >> 1) & 1); ++rep) {
        {
            PTRS();
            pg8::Gemm g{xb, (which ? W1tB : W1tA), NTOK, 2 * DFF, DM, DM, DM, nullptr, nullptr}; pg8::StaticOrder S; S.init(NTOK, 2 * DFF, G, bx);
            pg8::EpiSwiglu E{H, part};
            if constexpr ((PHMASK >> 0) & 1) pg8::gemm_phase<pg8::EpiSwiglu>(lds, g, S, E, wave);
            if (bx >= 128) {
                LAUNDER_TID();
                const int gwl = (bx - 128) * 8 + wave; LAS float* scr = (LAS float*)(lds + wave * 16640);
                if (it == 0) conv_job(ap, ws, 0, 0x76, gwl, 1024, scr, lane);
                else if (it == 1) { conv_job(ap, ws, 0, 0x08, gwl, 1024, scr, lane); conv_job(ap, ws, 1, 0x71, gwl, 1024, scr, lane); }
                else if (it == 2) conv_job(ap, ws, 1, 0x06, gwl, 1024, scr, lane);
                else conv_job(ap, ws, 1, 0x08, gwl, 1024, scr, lane);
                if (it == 2) g_job(ap->in[9] + (size_t)512 * DM, Gt, lds, tid, lane, wave, bx - 128, 128);
            }
        }
        GRID_SYNC(); }
        for (int rep = 0; rep < 1 + ((PROBE_DUP >> 7) & 1); ++rep) {
        {
            PTRS();
            pg8::Gemm g{H, (which ? W2tB : W2tA), NTOK, DM, DFF, DFF, DFF, nullptr, nullptr}; pg8::StaticOrder S; S.init(NTOK, DM, G, bx);
            const bool probe0 = ((PROBE_DUP >> 7) & 1) && rep == 0;
            if (((PROBE_DUP >> 7) & 1) && probe0) {
                pg8::EpiResid<0, false> E{(it == 0) ? x_in : (const float*)R, R, xb, part, nullptr, nullptr};
                if constexpr ((PROBE_DUP >> 7) & 1) pg8::gemm_phase<pg8::EpiResid<0, false>>(lds, g, S, E, wave);
            } else if (it == 3) {
                pg8::EpiResid<1, true> E{(const float*)R, R, xb, part, ap->in[14], (unsigned*)(ws + 16384)};
                if constexpr ((PHMASK >> 1) & 1) pg8::gemm_phase<pg8::EpiResid<1, true>>(lds, g, S, E, wave);
            } else {
                pg8::EpiResid<1, false> E{(it == 0) ? x_in : (const float*)R, R, xb, part, nullptr, nullptr};
                if constexpr ((PHMASK >> 1) & 1) pg8::gemm_phase<pg8::EpiResid<1, false>>(lds, g, S, E, wave);
            }
        }
        if (it < 3 || ((PROBE_DUP >> 7) & 1)) GRID_SYNC(); }
        if (which == 0) {
            for (int rep = 0; rep < 1 + ((PROBE_DUP >> 2) & 1); ++rep) {
            {
                PTRS();
                pg8::Gemm g{xb, Wint, NTOK, 3072, DM, DM, DM, Wint + (size_t)3072 * DM, xb};
                pg8::DualOrder S; S.s1.init(NTOK, 3072, G, bx); S.s2.init(1024, NTOK, G, bx);
                pg8::EpiInDual E{pg8::EpiMixIn{Z, part, ap->in[6] + (size_t)l * 2048}, pg8::EpiColScale{VU, NTOK, part}};
                if constexpr ((PHMASK >> 2) & 1) pg8::gemm_phase<pg8::EpiInDual, pg8::DualOrder>(lds, g, S, E, wave);
            }
            GRID_SYNC(); }
            for (int rep = 0; rep < 1 + ((PROBE_DUP >> 3) & 1); ++rep) {
            if constexpr ((PHMASK >> 8) & 1) {
                LAUNDER_TID(); PTRS();
                LAS unsigned char* scr = lds + 16384 + wave * 9216;
                for (int item = gw; item < 2048; item += NGW) {
                    const int hq = item & 1, ch = (item >> 1) & 511, b = item >> 10;
                    const bf16_t* src = VU + (size_t)(512 + ch) * NTOK + b * SEQ + hq * 4096;
#pragma unroll
                    for (int i = 0; i < 8; ++i) { const int c = lane + 64 * i; const u32x4 v = *(const u32x4*)(src + c * 8); *(LAS u32x4*)(scr + (c >> 3) * 144 + (c & 7) * 16) = v; }
                    LDS_WAIT();
#pragma unroll
                    for (int ps = 0; ps < 8; ++ps) {
                        const int t2 = 8 * ps + (lane >> 3), q = lane & 7; unsigned e[8];
#pragma unroll
                        for (int k = 0; k < 8; ++k) e[k] = *(const LAS unsigned short*)(scr + (8 * q + k) * 144 + 2 * t2);
                        u32x4 o; o.x = e[0] | (e[1] << 16); o.y = e[2] | (e[3] << 16); o.z = e[4] | (e[5] << 16); o.w = e[6] | (e[7] << 16);
                        *(u32x4*)(Xa + ((size_t)((b * 512 + ch) * 64 + t2)) * 128 + hq * 64 + 8 * q) = o;
                    }
                    LDS_WAIT();
                }
                asm volatile("s_waitcnt vmcnt(0)" ::: "memory"); __syncthreads();
                if constexpr ((PHMASK >> 4) & 1) {
                    pg8::Gemm g{Dt, Xa, 256, 65536, 128, 128, 128, nullptr, nullptr}; pg8::OneUnit S1{bx};
                    pg8::EpiDftA E{Ap, tab, 0.08838834764831845f};
                    pg8::gemm_phase<pg8::EpiDftA, pg8::OneUnit>(lds, g, S1, E, wave);
                }
                LAS float* tb = (LAS float*)lds;
                const float* rpb = ap->in[7] + (size_t)l * 8 * 15 * 31;
                for (int i = tid; i < 8 * 15 * 32; i += 512) tb[i] = ((i & 31) < 31) ? rpb[(i >> 5) * 31 + (i & 31)] * LOG2E : -INFINITY;
                __syncthreads();
                const int q = lane & 15, gq = lane >> 4;
                for (int pass = 0; pass < 4; ++pass) {
                    const int up = pass * 256 + (bx >> 3) * 8 + wave;
                    const int h = bx & 7, j = up & 3, r = (up >> 2) & 127, b = up >> 9;
                    const int rowq = b * SEQ + r * 64 + 16 * j + q;
                    const bf16_t* qp = Z + (size_t)rowq * ZLD + h * 64 + 8 * gq;
                    const bf16x8 qf0 = *(const bf16x8*)qp, qf1 = *(const bf16x8*)(qp + 32);
                    const int rs = min(max(r - 4, 0), 120), bs = min(max(16 * j - 8, 0), 32);
                    f32x4 s[8][2];
                    const int kap_lo = 8 * (q >> 2) + (q & 3);
                    const int G0 = (b * SEQ + rs * 64 + bs) >> 3;
                    const unsigned klane = (unsigned)((q >> 2) * ZLD + (q & 3) * 32 + 8 * gq), vlane = (unsigned)(gq * 512 + q * 8);
                    const bf16_t* kb0 = Z + (size_t)(h * 2048 + G0) * ZLD + 512;
                    const bf16_t* vb0 = VU + (size_t)(h * 2048 + G0) * 512;
                    bf16x8 kf[8][2][2];
#pragma unroll
                    for (int u = 0; u < 8; ++u)
#pragma unroll
                        for (int tau = 0; tau < 2; ++tau) {
                            const bf16_t* kp = kb0 + (size_t)(u * 8) * ZLD + tau * 256 + klane;
                            kf[u][tau][0] = *(const bf16x8*)kp; kf[u][tau][1] = *(const bf16x8*)(kp + 128);
                        }
                    __builtin_amdgcn_sched_barrier(0);
#pragma unroll
                    for (int u = 0; u < 8; ++u)
#pragma unroll
                        for (int tau = 0; tau < 2; ++tau) {
                            f32x4 c = (f32x4){0.f, 0.f, 0.f, 0.f};
                            c = __builtin_amdgcn_mfma_f32_16x16x32_bf16(kf[u][tau][0], qf0, c, 0, 0, 0);
                            c = __builtin_amdgcn_mfma_f32_16x16x32_bf16(kf[u][tau][1], qf1, c, 0, 0, 0);
                            s[u][tau] = c;
                        }
                    __builtin_amdgcn_sched_barrier(0);
                    bf16x8 vf[8][4];
#pragma unroll
                    for (int u = 0; u < 8; ++u)
#pragma unroll
                        for (int mt = 0; mt < 4; ++mt) vf[u][mt] = *(const bf16x8*)(vb0 + (size_t)(u * 8) * 512 + mt * 128 + vlane);
                    __builtin_amdgcn_sched_barrier(0);
                    const int qcol = 16 * j + q, wst = min(max(qcol - 8, 0), 48);
                    int adr[8];
#pragma unroll
                    for (int k = 0; k < 8; ++k) {
                        const int kc = bs + 8 * gq + k; const int dc = min(max(kc - qcol, -15), 15) + 15;
                        adr[k] = ((h * 15 + (rs - r + 7)) * 32 + ((kc < wst || kc >= wst + 16) ? 31 : dc)) * 4;
                    }
                    float mx = -INFINITY;
#pragma unroll
                    for (int u = 0; u < 8; ++u)
#pragma unroll
                        for (int tau = 0; tau < 2; ++tau)
#pragma unroll
                            for (int i = 0; i < 4; ++i) {
                                const float bias = *(const LAS float*)((const LAS unsigned char*)tb + adr[4 * tau + i] + u * 128);
                                const float v = s[u][tau][i] * (0.125f * LOG2E) + bias;
                                s[u][tau][i] = v; mx = fmaxf(mx, v);
                            }
                    mx = fmaxf(mx, sx(mx, 16, lane)); mx = fmaxf(mx, sx(mx, 32, lane));
                    float sum = 0.f;
#pragma unroll
                    for (int u = 0; u < 8; ++u)
#pragma unroll
                        for (int tau = 0; tau < 2; ++tau)
#pragma unroll
                            for (int i = 0; i < 4; ++i) { const float p = fast_exp2(s[u][tau][i] - mx); s[u][tau][i] = p; sum += p; }
                    sum += sx(sum, 16, lane); sum += sx(sum, 32, lane);
                    f32x4 o[4];
#pragma unroll
                    for (int mt = 0; mt < 4; ++mt) o[mt] = (f32x4){0.f, 0.f, 0.f, 0.f};
#pragma unroll
                    for (int u = 0; u < 8; ++u) {
                        const u32x4 pw = pg8::pack8(s[u][0], s[u][1]);
                        const bf16x8 pb = __builtin_bit_cast(bf16x8, pw);
#pragma unroll
                        for (int mt = 0; mt < 4; ++mt) {
                            o[mt] = __builtin_amdgcn_mfma_f32_16x16x32_bf16(vf[u][mt], pb, o[mt], 0, 0, 0);
                        }
                    }
                    const float inv = 1.0f / sum;
                    if (((PROBE_DUP >> 3) & 1) && rep == 0 && inv > 0.f) continue;
#pragma unroll
                    for (int mt = 0; mt < 4; ++mt) {
                        u32x2 w; w.x = cvt_pk_bf16(o[mt][0] * inv, o[mt][1] * inv); w.y = cvt_pk_bf16(o[mt][2] * inv, o[mt][3] * inv);
                        *(u32x2*)(Z + (size_t)rowq * ZLD + h * 64 + 16 * mt + 4 * gq) = w;
                    }
                }
                __syncthreads();
            }
            GRID_SYNC(); }
            for (int rep = 0; rep < 1 + ((PROBE_DUP >> 5) & 1); ++rep) {
            {
                PTRS();
                pg8::Gemm g{Eb, Ap, 256, 65536, 256, 256, 256, nullptr, nullptr}; pg8::StaticOrder S; S.init(256, 65536, G, bx);
                pg8::EpiDftB E{FW, 0.125f};
                if constexpr ((PHMASK >> 5) & 1) pg8::gemm_phase<pg8::EpiDftB>(lds, g, S, E, wave);
            }
            GRID_SYNC(); }
            for (int rep = 0; rep < 1 + ((PROBE_DUP >> 6) & 1); ++rep) {
            {
                PTRS();
                pg8::Gemm g{Z, Wna_t, NTOK, DM, 512, ZLD, 512, nullptr, nullptr}; pg8::StaticOrder S; S.init(NTOK, DM, G, bx);
                pg8::EpiGate<false> E{Z + 1024, Mb};
                if constexpr ((PHMASK >> 6) & 1) pg8::gemm_phase<pg8::EpiGate<false>>(lds, g, S, E, wave);
            }
            {
                PTRS();
                pg8::Gemm g{FW, Gt, NTOK, DM, DM, DM, DM, nullptr, nullptr}; pg8::StaticOrder S; S.init(NTOK, DM, G, bx);
                pg8::EpiGate<true> E{Z + 2048, Mb};
                if constexpr ((PHMASK >> 7) & 1) pg8::gemm_phase<pg8::EpiGate<true>>(lds, g, S, E, wave);
            }
            GRID_SYNC(); }
            for (int rep = 0; rep < 1 + ((PROBE_DUP >> 8) & 1); ++rep) {
            {
                PTRS();
                pg8::Gemm g{Mb, Wo_t, NTOK, DM, DM, DM, DM, nullptr, nullptr}; pg8::StaticOrder S; S.init(NTOK, DM, G, bx);
                if (((PROBE_DUP >> 8) & 1) && rep == 0) {
                    pg8::EpiResid<0, false> E{R, R, xb, part, nullptr, nullptr};
                    if constexpr ((PROBE_DUP >> 8) & 1) pg8::gemm_phase<pg8::EpiResid<0, false>>(lds, g, S, E, wave);
                } else {
                    pg8::EpiResid<2, false> E{R, R, xb, part, nullptr, nullptr};
                    if constexpr ((PHMASK >> 1) & 1) pg8::gemm_phase<pg8::EpiResid<2, false>>(lds, g, S, E, wave);
                }
            }
            GRID_SYNC(); }
        }
    }
#ifdef PROBE_SYNC
    for (int i = 0; i < PROBE_SYNC; ++i) GRID_SYNC();
#endif
}

extern "C" void kernel_launch(void* const* d_in, const int* in_sizes, int n_in, void* d_out, int out_size, void* d_ws, size_t ws_size, hipStream_t stream) {
    static int grid = 0;
    if (grid == 0) {
        if (n_in != 15 || out_size != NTOK * DM || ws_size < WS_END) { fprintf(stderr, "kernel_launch: unexpected shapes (n_in %d out %d ws %zu)\n", n_in, out_size, ws_size); grid = -1; return; }
        int dev = 0, cus = 0, per_cu = 0;
        hipGetDevice(&dev); hipDeviceGetAttribute(&cus, hipDeviceAttributeMultiprocessorCount, dev);
        if (hipFuncSetAttribute((const void*)fwd_kernel, hipFuncAttributeMaxDynamicSharedMemorySize, LDS_BYTES) != hipSuccess) { fprintf(stderr, "kernel_launch: hipFuncSetAttribute failed\n"); grid = -1; return; }
        if (hipOccupancyMaxActiveBlocksPerMultiprocessor(&per_cu, (const void*)fwd_kernel, 512, LDS_BYTES) != hipSuccess || per_cu < 1) { fprintf(stderr, "kernel_launch: occupancy query says %d\n", per_cu); (void)hipGetLastError(); grid = -1; return; }
        if (cus * per_cu < 256) { fprintf(stderr, "kernel_launch: needs 256 co-resident workgroups, device holds %d\n", cus * per_cu); grid = -1; return; }
        grid = 256;
    }
    if (grid < 0) return;
    Args a{};
    for (int i = 0; i < 15; ++i) a.in[i] = (const float*)d_in[i];
    a.out = (float*)d_out; a.ws = (unsigned char*)d_ws;
    void* args[] = {&a};
    hipError_t e = hipLaunchCooperativeKernel((const void*)fwd_kernel, dim3(grid), dim3(512), args, LDS_BYTES, stream);
    if (e != hipSuccess) fprintf(stderr, "cooperative launch failed: %s (grid %d)\n", hipGetErrorString(e), grid);
}
```

```cpp
#include <hip/hip_runtime.h>
#include <hip/hip_cooperative_groups.h>
#include <cstdio>
#include <cstdint>
namespace cg = cooperative_groups;

#define LAS __attribute__((address_space(3)))
typedef unsigned short bf16_t;
typedef short bf16x8 __attribute__((ext_vector_type(8)));
typedef float f32x4 __attribute__((ext_vector_type(4)));
typedef float f32x2 __attribute__((ext_vector_type(2)));
typedef unsigned u32x4 __attribute__((ext_vector_type(4)));
typedef unsigned u32x2 __attribute__((ext_vector_type(2)));

constexpr int NTOK = 16384, DM = 1024, DFF = 2816, SEQ = 8192;
constexpr int ZLD = 3072;
constexpr float RMS_EPS = 1e-6f;
constexpr float LOG2E = 1.4426950408889634f;

constexpr size_t MiB = 1u << 20;
constexpr size_t WS_TAB = 1 * MiB;
constexpr size_t WS_DT = 1 * MiB + 65536;
constexpr size_t WS_EB = 1 * MiB + 131072;
constexpr size_t WS_PART = 2 * MiB;
constexpr size_t WS_W1A = 4 * MiB, WS_W2A = 15 * MiB, WS_W1B = 21 * MiB, WS_W2B = 32 * MiB;
constexpr size_t WS_WIN = 38 * MiB, WS_WNA = 46 * MiB, WS_GT = 47 * MiB, WS_WO = 49 * MiB;
constexpr size_t WS_XB = 52 * MiB;
constexpr size_t WS_Z = 84 * MiB;
constexpr size_t WS_H = 84 * MiB;
constexpr size_t WS_VU = 180 * MiB;
constexpr size_t WS_XA = 212 * MiB;
constexpr size_t WS_END = 244 * MiB;

constexpr int LDS_BYTES = 147456;
constexpr int MISC_OFF = LDS_BYTES - 256;
#ifndef PROBE_DUP
#define PROBE_DUP 0
#endif
#ifndef PHMASK
#define PHMASK 0xFFFF
#endif

__device__ __forceinline__ unsigned cvt_pk_bf16(float lo, float hi) { unsigned r; asm volatile("v_cvt_pk_bf16_f32 %0, %1, %2" : "=v"(r) : "v"(lo), "v"(hi)); return r; }
__device__ __forceinline__ float bf_lo(unsigned w) { return __uint_as_float(w << 16); }
__device__ __forceinline__ float bf_hi(unsigned w) { return __uint_as_float(w & 0xffff0000u); }
__device__ __forceinline__ float fast_exp2(float x) { return __builtin_amdgcn_exp2f(x); }
__device__ __forceinline__ float fast_rcp(float x) { return __builtin_amdgcn_rcpf(x); }
__device__ __forceinline__ float sigmoidf_(float x) { return fast_rcp(1.0f + fast_exp2(-x * LOG2E)); }
__device__ __forceinline__ float sx(float v, int mask, int lane) { return __int_as_float(__builtin_amdgcn_ds_bpermute((lane ^ mask) << 2, __float_as_int(v))); }
__device__ __forceinline__ float wave_sum(float v, int lane) {
#pragma unroll
    for (int o = 1; o < 64; o <<= 1) v += sx(v, o, lane);
    return v;
}
__device__ __forceinline__ float row_rstd(const float* part, int row) {
    const f32x4 a = *(const f32x4*)(part + (size_t)row * 4);
    return rsqrtf(((a.x + a.y) + (a.z + a.w)) * (1.0f / 1024.0f) + RMS_EPS);
}
__device__ __forceinline__ unsigned lane_id_fresh() { unsigned ones = ~0u; asm volatile("" : "+s"(ones)); return __builtin_amdgcn_mbcnt_hi(ones, __builtin_amdgcn_mbcnt_lo(ones, 0u)); }
#define WT_RSRC(ptr, bytes) __builtin_amdgcn_make_buffer_rsrc((void*)(ptr), (short)0, (int)(bytes), 0x00020000)
#define WT16(rsrc, off_bytes, val) __builtin_amdgcn_raw_buffer_store_b128((val), (rsrc), (unsigned)(off_bytes), 0, 16)
#define LDS_WAIT() asm volatile("s_waitcnt lgkmcnt(0)" ::: "memory")

namespace pg8 {
constexpr int BM = 256, BK = 64, HALF = 128, HTB = HALF * BK * 2, STAGE_BYTES = 8 * HTB, NXCD = 8, WGM = 8;
__host__ __device__ __forceinline__ int lds_byte(int r, int c) { const int st = (r >> 4) * 2 + (c >> 5), rr = r & 15, cc = c & 31, ob = rr * 64 + cc * 2; return st * 1024 + (ob ^ (((ob >> 9) & 1) << 5)); }
__host__ __device__ __forceinline__ void stage_rc(int b, int& R, int& C) { const int st = b / 1024, sb = b % 1024, swz = sb ^ (((sb >> 9) & 1) << 5); R = (st >> 1) * 16 + swz / 64; C = (st & 1) * 32 + (swz % 64) / 2; }
__host__ __device__ __forceinline__ int perm32(int rho) { const int n = rho >> 4, i = rho & 15; return 8 * (i >> 2) + 4 * n + (i & 3); }

struct Unit { int pm, pn, kind; };
struct Gemm { const bf16_t* A; const bf16_t* Bt; int M, N, K, lda, ldb; const bf16_t* A2; const bf16_t* Bt2; };

struct StaticOrder {
    int nM, nN, nwg, G, c;
    __host__ __device__ void init(int M, int N, int G_, int c_) { nM = M / BM; nN = N / BM; nwg = nM * nN; G = G_; c = c_; }
    __host__ __device__ bool next(int i, Unit& u) const { const long L = (long)i * G + c; if (L >= nwg) return false; map((int)L, u); return true; }
    __host__ __device__ void map(int L, Unit& u) const {
        int wgid = L; { const int q = nwg / NXCD, r = nwg % NXCD, xcd = wgid % NXCD, off = wgid / NXCD; wgid = (xcd < r ? xcd * (q + 1) : r * (q + 1) + (xcd - r) * q) + off; }
        const int nig = WGM * nN, gid = wgid / nig, fm = gid * WGM, gsz = (nM - fm) < WGM ? (nM - fm) : WGM;
        u.pm = fm + ((wgid % nig) % gsz); u.pn = (wgid % nig) / gsz; u.kind = 0;
    }
};
struct DualOrder {
    StaticOrder s1, s2;
    __device__ __forceinline__ bool next(int i, Unit& u) const {
        const int L = i * s1.G + s1.c;
        if (L < s1.nwg) { s1.map(L, u); return true; }
        if (L - s1.nwg < s2.nwg) { s2.map(L - s1.nwg, u); u.kind = 1; return true; }
        return false;
    }
};

typedef f32x4 Acc[2][2][4][2];

__device__ __forceinline__ u32x4 pack8(const f32x4 v0, const f32x4 v1) {
    u32x4 w; w.x = cvt_pk_bf16(v0[0], v0[1]); w.y = cvt_pk_bf16(v0[2], v0[3]); w.z = cvt_pk_bf16(v1[0], v1[1]); w.w = cvt_pk_bf16(v1[2], v1[3]); return w;
}

struct EpiSwiglu {
    static constexpr bool PERM = true; static constexpr bool HAS_PRE = true;
    bf16_t* H; const float* part;
    __device__ __forceinline__ f32x4 pre_load(const Unit& u, int tid) const { return *(const f32x4*)(part + (size_t)(u.pm * BM + (tid & 255)) * 4); }
    __device__ __forceinline__ void pre_store(const f32x4 a, int tid, LAS float* tab) const { if (tid < 256) tab[tid] = rsqrtf(((a.x + a.y) + (a.z + a.w)) * (1.0f / 1024.0f) + RMS_EPS); }
    __device__ __forceinline__ void operator()(const Acc& acc, const Unit& u, int wr, int wc, int fr, int fq, const LAS float* p) const {
        const int row0 = u.pm * BM + wr * 64 + fr, col0 = u.pn * HALF + wc * 32 + 8 * fq;
#pragma unroll
        for (int ai = 0; ai < 2; ++ai)
#pragma unroll
            for (int m = 0; m < 4; ++m) {
                const int row = row0 + ai * HALF + m * 16; const float rs = p[ai * HALF + wr * 64 + m * 16 + fr];
                f32x4 h[2];
#pragma unroll
                for (int n = 0; n < 2; ++n) {
                    const f32x4 g = acc[ai][0][m][n] * rs, up = acc[ai][1][m][n] * rs;
#pragma unroll
                    for (int j = 0; j < 4; ++j) h[n][j] = g[j] * sigmoidf_(g[j]) * up[j];
                }
                WT16(WT_RSRC(H, NTOK * DFF * 2), (unsigned)(row * DFF + col0) * 2u, pack8(h[0], h[1]));
                if (m & 1) asm volatile("" ::: "memory");
            }
    }
};
template <int ALPHA2, bool FIN> struct EpiResid {
    static constexpr bool PERM = true; static constexpr bool HAS_PRE = false;
    const float* base; float* out; bf16_t* xb; float* part;
    static constexpr float alpha = 0.5f * ALPHA2; static constexpr int fin = FIN ? 1 : 0;
    const float* gfin; unsigned* cnt;
    __device__ __forceinline__ void operator()(Acc& acc, const Unit& u, int wr, int wc, int fr, int fq) const {
        LAS float* P = (LAS float*)(uintptr_t)131072;
        const unsigned off0 = (unsigned)((u.pm * BM + wr * 64 + fr) * DM + u.pn * BM + wc * 32 + 8 * fq);
#pragma unroll
        for (int h4 = 0; h4 < 4; ++h4) {
            const int ai = h4 >> 1, mb = (h4 & 1) * 2;
            f32x4 pre[2][2][2];
#pragma unroll
            for (int mm = 0; mm < 2; ++mm)
#pragma unroll
                for (int bj = 0; bj < 2; ++bj)
#pragma unroll
                    for (int n = 0; n < 2; ++n) pre[mm][bj][n] = *(const f32x4*)(base + off0 + (unsigned)((ai * HALF + (mb + mm) * 16) * DM + bj * HALF + n * 4));
            asm volatile("" ::: "memory");
#pragma unroll
            for (int mm = 0; mm < 2; ++mm) {
                const int m = mb + mm;
                const unsigned off = off0 + (unsigned)((ai * HALF + m * 16) * DM); float ss = 0.f;
#pragma unroll
                for (int bj = 0; bj < 2; ++bj) {
                    const unsigned o2 = off + (unsigned)(bj * HALF);
                    const f32x4 o0 = pre[mm][bj][0] + acc[ai][bj][m][0] * alpha, o1 = pre[mm][bj][1] + acc[ai][bj][m][1] * alpha;
                    ss += ((o0[0] * o0[0] + o0[1] * o0[1]) + (o0[2] * o0[2] + o0[3] * o0[3])) + ((o1[0] * o1[0] + o1[1] * o1[1]) + (o1[2] * o1[2] + o1[3] * o1[3]));
                    if (!fin) { __builtin_nontemporal_store(o0, (f32x4*)(out + o2)); __builtin_nontemporal_store(o1, (f32x4*)(out + o2 + 4)); WT16(WT_RSRC(xb, NTOK * DM * 2), o2 * 2u, pack8(o0, o1)); }
                    else { acc[ai][bj][m][0] = o0; acc[ai][bj][m][1] = o1; }
                }
                ss += sx(ss, 16, fr + 16 * fq); ss += sx(ss, 32, fr + 16 * fq);
                if (fq == 0) P[(ai * HALF + wr * 64 + m * 16 + fr) * 4 + wc] = ss;
            }
            asm volatile("" ::: "memory");
        }
        asm volatile("s_waitcnt lgkmcnt(0)" ::: "memory"); __builtin_amdgcn_s_barrier(); asm volatile("" ::: "memory");
        const int wid = wr * 4 + wc, lane = fq * 16 + fr, t = wid * 64 + lane;
        if (!fin) {
            if (t < 256) { const f32x4 p = *(const LAS f32x4*)(P + t * 4); part[(size_t)(u.pm * BM + t) * 4 + u.pn] = (p.x + p.y) + (p.z + p.w); }
        } else {
            LAS float* S = P + 1024; LAS unsigned* flag = (LAS unsigned*)(P + 1024 + 256);
            unsigned* pc = cnt + 64 * u.pm;
            if (t < 256) { const f32x4 p = *(const LAS f32x4*)(P + t * 4);
                __hip_atomic_store((unsigned*)part + (size_t)(u.pm * BM + t) * 4 + u.pn, __float_as_uint((p.x + p.y) + (p.z + p.w)), __ATOMIC_RELAXED, __HIP_MEMORY_SCOPE_AGENT); }
            asm volatile("s_waitcnt vmcnt(0)" ::: "memory");
            if (wid < 4 && lane == 0) __hip_atomic_fetch_add(pc, 1u, __ATOMIC_RELAXED, __HIP_MEMORY_SCOPE_AGENT);
            if (wid == 0) {
                unsigned spins = 0;
                while ((unsigned)__builtin_amdgcn_readfirstlane(__hip_atomic_load(pc, __ATOMIC_RELAXED, __HIP_MEMORY_SCOPE_AGENT)) < 16u && ++spins < (1u << 22)) __builtin_amdgcn_s_sleep(2);
                __builtin_amdgcn_fence(__ATOMIC_ACQUIRE, "agent");
                if (lane == 0) flag[0] = (spins >= (1u << 22)) ? 1u : 0u;
            }
            asm volatile("s_waitcnt vmcnt(0) lgkmcnt(0)" ::: "memory"); __builtin_amdgcn_s_barrier(); asm volatile("" ::: "memory");
            if (t < 256) {
                unsigned* sl = (unsigned*)part + (size_t)(u.pm * BM + t) * 4;
                const float a0 = __uint_as_float(__hip_atomic_load(sl + 0, __ATOMIC_RELAXED, __HIP_MEMORY_SCOPE_AGENT)), a1 = __uint_as_float(__hip_atomic_load(sl + 1, __ATOMIC_RELAXED, __HIP_MEMORY_SCOPE_AGENT));
                const float a2 = __uint_as_float(__hip_atomic_load(sl + 2, __ATOMIC_RELAXED, __HIP_MEMORY_SCOPE_AGENT)), a3 = __uint_as_float(__hip_atomic_load(sl + 3, __ATOMIC_RELAXED, __HIP_MEMORY_SCOPE_AGENT));
                S[t] = (flag[0] != 0u) ? __builtin_nanf("") : rsqrtf(((a0 + a1) + (a2 + a3)) * (1.0f / 1024.0f) + RMS_EPS);
            }
            asm volatile("s_waitcnt vmcnt(0) lgkmcnt(0)" ::: "memory"); __builtin_amdgcn_s_barrier(); asm volatile("" ::: "memory");
            f32x4 gv[2][2];
#pragma unroll
            for (int bj = 0; bj < 2; ++bj)
#pragma unroll
                for (int n = 0; n < 2; ++n) gv[bj][n] = *(const f32x4*)(gfin + u.pn * BM + wc * 32 + 8 * fq + bj * HALF + 4 * n);
#pragma unroll
            for (int ai = 0; ai < 2; ++ai)
#pragma unroll
                for (int m = 0; m < 4; ++m) {
                    const float rs = S[ai * HALF + wr * 64 + m * 16 + fr];
                    const unsigned off = off0 + (unsigned)((ai * HALF + m * 16) * DM);
#pragma unroll
                    for (int bj = 0; bj < 2; ++bj) {
                        *(f32x4*)(out + off + (unsigned)(bj * HALF)) = acc[ai][bj][m][0] * rs * gv[bj][0];
                        *(f32x4*)(out + off + (unsigned)(bj * HALF) + 4) = acc[ai][bj][m][1] * rs * gv[bj][1];
                    }
                }
        }
        asm volatile("s_waitcnt lgkmcnt(0)" ::: "memory"); __builtin_amdgcn_s_barrier(); asm volatile("" ::: "memory");
    }
};
struct EpiMixIn {
    static constexpr bool PERM = true; static constexpr bool HAS_PRE = false;
    bf16_t* Z; const float* part; const float* gbias;
    __device__ __forceinline__ void operator()(const Acc& acc, const Unit& u, int wr, int wc, int fr, int fq) const {
        const int row0 = u.pm * BM + wr * 64 + fr, col0 = u.pn * BM + wc * 32 + 8 * fq; const bool gate = u.pn >= 4, kt = (u.pn >> 1) == 1;
        f32x4 bv[2][2];
#pragma unroll
        for (int bj = 0; bj < 2; ++bj)
#pragma unroll
            for (int n = 0; n < 2; ++n) bv[bj][n] = gate ? *(const f32x4*)(gbias + (col0 - 1024) + bj * HALF + 4 * n) : (f32x4){0.f, 0.f, 0.f, 0.f};
        float rsv[2][4];
#pragma unroll
        for (int ai = 0; ai < 2; ++ai)
#pragma unroll
            for (int m = 0; m < 4; ++m) rsv[ai][m] = row_rstd(part, row0 + ai * HALF + m * 16);
#pragma unroll
        for (int ai = 0; ai < 2; ++ai)
#pragma unroll
            for (int m = 0; m < 4; ++m) {
                const int row = row0 + ai * HALF + m * 16; const float rs = rsv[ai][m];
#pragma unroll
                for (int bj = 0; bj < 2; ++bj) {
                    f32x4 v[2];
#pragma unroll
                    for (int n = 0; n < 2; ++n) {
                        v[n] = acc[ai][bj][m][n] * rs;
                        if (gate) {
                            v[n] = v[n] + bv[bj][n];
#pragma unroll
                            for (int j = 0; j < 4; ++j) v[n][j] = sigmoidf_(v[n][j]);
                        }
                    }
                    const int col = col0 + bj * HALF;
                    size_t zoff = (size_t)row * ZLD + col;
                    if (kt) {
                        const int hh = (col - 512) >> 6, d0 = (col - 512) & 63;
                        zoff = (size_t)(hh * 2048 + (row >> 3)) * ZLD + 512 + ((((((row >> 2) & 1) * 2 + (d0 >> 5)) * 4 + (row & 3)) * 4 + ((d0 >> 3) & 3)) * 8);
                    }
                    if (gate) __builtin_amdgcn_raw_buffer_store_b128(pack8(v[0], v[1]), WT_RSRC(Z, NTOK * ZLD * 2), (unsigned)zoff * 2u, 0, 18); else WT16(WT_RSRC(Z, NTOK * ZLD * 2), (unsigned)zoff * 2u, pack8(v[0], v[1]));
                }
                if (m & 1) asm volatile("" ::: "memory");
            }
    }
};
struct EpiColScale {
    static constexpr bool PERM = true; static constexpr bool HAS_PRE = false;
    bf16_t* O; int ldc; const float* part;
    __device__ __forceinline__ void operator()(const Acc& acc, const Unit& u, int wr, int wc, int fr, int fq) const {
        const int row0 = u.pm * BM + wr * 64 + fr, col0 = u.pn * BM + wc * 32 + 8 * fq;
        f32x4 cs[2][2];
#pragma unroll
        for (int bj = 0; bj < 2; ++bj)
#pragma unroll
            for (int n = 0; n < 2; ++n)
#pragma unroll
                for (int j = 0; j < 4; ++j) cs[bj][n][j] = row_rstd(part, col0 + bj * HALF + 4 * n + j);
#pragma unroll
        for (int ai = 0; ai < 2; ++ai)
#pragma unroll
            for (int m = 0; m < 4; ++m) {
                const int row = row0 + ai * HALF + m * 16;
#pragma unroll
                for (int bj = 0; bj < 2; ++bj)
                {
                    const int col = col0 + bj * HALF;
                    size_t ooff = (size_t)row * ldc + col;
                    if (u.pm < 2) ooff = ((size_t)(((row >> 6) * 2048 + (col >> 3)) * 4 + ((row >> 4) & 3))) * 128 + (row & 15) * 8;
                    WT16(WT_RSRC(O, 1024 * NTOK * 2), (unsigned)ooff * 2u, pack8(acc[ai][bj][m][0] * cs[bj][0], acc[ai][bj][m][1] * cs[bj][1]));
                }
            }
    }
};
struct EpiInDual {
    static constexpr bool PERM = true; static constexpr bool HAS_PRE = false;
    EpiMixIn e0; EpiColScale e1;
    __device__ __forceinline__ void operator()(const Acc& acc, const Unit& u, int wr, int wc, int fr, int fq) const { if (u.kind == 0) e0(acc, u, wr, wc, fr, fq); else e1(acc, u, wr, wc, fr, fq); }
};
template <bool ADD> struct EpiGate {
    static constexpr bool PERM = true; static constexpr bool HAS_PRE = false;
    const bf16_t* G; bf16_t* Mb;
    __device__ __forceinline__ void operator()(const Acc& acc, const Unit& u, int wr, int wc, int fr, int fq) const {
        const int row0 = u.pm * BM + wr * 64 + fr, col0 = u.pn * BM + wc * 32 + 8 * fq;
#pragma unroll
        for (int ai = 0; ai < 2; ++ai) {
            u32x4 gw[4][2], pw[4][2];
#pragma unroll
            for (int m = 0; m < 4; ++m)
#pragma unroll
                for (int bj = 0; bj < 2; ++bj) {
                    const int row = row0 + ai * HALF + m * 16;
                    gw[m][bj] = *(const u32x4*)(G + (size_t)row * ZLD + col0 + bj * HALF);
                    if (ADD) pw[m][bj] = *(const u32x4*)(Mb + (size_t)row * DM + col0 + bj * HALF);
                }
            asm volatile("" ::: "memory");
#pragma unroll
            for (int m = 0; m < 4; ++m)
#pragma unroll
                for (int bj = 0; bj < 2; ++bj) {
                    const int row = row0 + ai * HALF + m * 16;
                    bf16_t* mp = Mb + (size_t)row * DM + col0 + bj * HALF;
                    const u32x4 g4 = gw[m][bj];
                    f32x4 v0 = acc[ai][bj][m][0], v1 = acc[ai][bj][m][1];
                    v0[0] *= bf_lo(g4.x); v0[1] *= bf_hi(g4.x); v0[2] *= bf_lo(g4.y); v0[3] *= bf_hi(g4.y);
                    v1[0] *= bf_lo(g4.z); v1[1] *= bf_hi(g4.z); v1[2] *= bf_lo(g4.w); v1[3] *= bf_hi(g4.w);
                    if (ADD) {
                        const u32x4 p4 = pw[m][bj];
                        v0[0] += bf_lo(p4.x); v0[1] += bf_hi(p4.x); v0[2] += bf_lo(p4.y); v0[3] += bf_hi(p4.y);
                        v1[0] += bf_lo(p4.z); v1[1] += bf_hi(p4.z); v1[2] += bf_lo(p4.w); v1[3] += bf_hi(p4.w);
                    }
                    WT16(WT_RSRC(Mb, NTOK * DM * 2), (unsigned)(row * DM + col0 + bj * HALF) * 2u, pack8(v0, v1));
                }
            asm volatile("" ::: "memory");
        }
    }
};
struct EpiDftA {
    static constexpr bool PERM = true; static constexpr bool HAS_PRE = false;
    bf16_t* Ap; const f32x2* tab; float scale;
    __device__ __forceinline__ void operator()(const Acc& acc, const Unit& u, int wr, int wc, int fr, int fq) const {
        const int nb = u.pn * BM + wc * 32 + 8 * fq, t2 = nb & 63;
#pragma unroll
        for (int m = 0; m < 4; ++m) {
            const int k1 = wr * 64 + m * 16 + fr;
            f32x2 cs[8];
            cs[0] = tab[(unsigned)(k1 * t2)]; const f32x2 w = tab[(unsigned)k1];
            cs[0].x *= scale; cs[0].y *= scale;
#pragma unroll
            for (int e = 1; e < 8; ++e) { cs[e].x = cs[e - 1].x * w.x - cs[e - 1].y * w.y; cs[e].y = cs[e - 1].y * w.x + cs[e - 1].x * w.y; }
#pragma unroll
            for (int bj = 0; bj < 2; ++bj) {
                const int n0 = nb + bj * HALF, ch = (n0 >> 6) & 511, b = n0 >> 15;
                const unsigned doff = (unsigned)(((b * 64 + (k1 & 63)) * 512 + ch) * 256 + (k1 >> 6) * 128 + t2);
                f32x4 re[2], im[2];
#pragma unroll
                for (int n = 0; n < 2; ++n)
#pragma unroll
                    for (int j = 0; j < 4; ++j) {
                        const float ar = acc[0][bj][m][n][j], ai_ = acc[1][bj][m][n][j]; const f32x2 c = cs[4 * n + j];
                        re[n][j] = ar * c.x + ai_ * c.y; im[n][j] = ai_ * c.x - ar * c.y;
                    }
                WT16(WT_RSRC(Ap, 65536 * 256 * 2), doff * 2u, pack8(re[0], re[1]));
                WT16(WT_RSRC(Ap, 65536 * 256 * 2), (doff + 64u) * 2u, pack8(im[0], im[1]));
            }
            asm volatile("" ::: "memory");
        }
    }
};
struct EpiDftB {
    static constexpr bool PERM = true; static constexpr bool HAS_PRE = false;
    bf16_t* FW; float scale;
    __device__ __forceinline__ void operator()(const Acc& acc, const Unit& u, int wr, int wc, int fr, int fq) const {
        const int nb = u.pn * BM + wc * 32 + 8 * fq;
#pragma unroll
        for (int bj = 0; bj < 2; ++bj) {
            const int n0 = nb + bj * HALF, ch = n0 & 511, k1lo = (n0 >> 9) & 63, b = n0 >> 15;
            const unsigned base = (unsigned)((b * SEQ + k1lo + 64 * wr + 128 * fr) * DM + ch);
#pragma unroll
            for (int ai = 0; ai < 2; ++ai)
#pragma unroll
                for (int m = 0; m < 4; ++m) {
                    WT16(WT_RSRC(FW, NTOK * DM * 2), (base + (unsigned)(128 * 16 * m * DM + ai * 512)) * 2u, pack8(acc[ai][bj][m][0] * scale, acc[ai][bj][m][1] * scale));
                    if (m & 1) asm volatile("" ::: "memory");
                }
        }
    }
};

struct OneUnit { int pn; __device__ __forceinline__ bool next(int i, Unit& u) const { if (i) return false; u.pm = 0; u.pn = pn; u.kind = 0; return true; } };
template <class Epi, class Sched = StaticOrder>
__device__ __forceinline__ void gemm_phase(LAS unsigned char* lds, const Gemm g, const Sched& S, const Epi& E, const int wave_) {
    int tid = wave_ * 64 + (int)lane_id_fresh(); asm volatile("" : "+v"(tid));
    const int wid = __builtin_amdgcn_readfirstlane(tid >> 6), lane = tid & 63, wr = wid >> 2, wc = wid & 3, fr = lane & 15, fq = lane >> 4;
    int K = g.K;
    asm volatile("" : "+s"(K));
    const int nt = K / BK;
    unsigned voffA[2], voffB[2];
#pragma unroll
    for (int i = 0; i < 2; ++i) { int R, C; stage_rc(tid * 16 + i * 8192, R, C); const int Rb = Epi::PERM ? ((R & ~31) + perm32(R & 31)) : R;
        voffA[i] = (unsigned)(R * g.lda + C) * 2u; voffB[i] = (unsigned)(Rb * g.ldb + C) * 2u; }
    const size_t kstep = (size_t)(BK * 2);
    const size_t hstepA = (size_t)HALF * g.lda * 2, hstepB = (size_t)HALF * g.ldb * 2;
    const size_t tstepA = 2 * hstepA, tstepB = 2 * hstepB;
    const unsigned ldsw = (unsigned)wid * 1024u;
    const int aoff = lds_byte(wr * 64 + fr, fq * 8), boff = lds_byte(wc * 32 + fr, fq * 8);
#define PG8_SA(b, h) (((b) * 2 + (h)) * HTB)
#define PG8_SB(b, h) ((4 + (b) * 2 + (h)) * HTB)
#define PG8_STAGE(bufoff, gbase, voff) do { _Pragma("unroll") for (int _i = 0; _i < 2; ++_i) \
        __builtin_amdgcn_global_load_lds((const unsigned*)((const char*)(gbase) + (voff)[_i]), (LAS unsigned*)(lds + (bufoff) + ldsw + _i * 8192), 16, 0, 0); } while (0)
#define PG8_LDA(dst, b, h) do { _Pragma("unroll") for (int m = 0; m < 4; ++m) _Pragma("unroll") for (int k = 0; k < 2; ++k) dst[m][k] = *(const LAS bf16x8*)(lds + PG8_SA(b, h) + aoff + m * 2048 + k * 1024); } while (0)
#define PG8_LDB(dst, b, h) do { _Pragma("unroll") for (int n = 0; n < 2; ++n) _Pragma("unroll") for (int k = 0; k < 2; ++k) dst[n][k] = *(const LAS bf16x8*)(lds + PG8_SB(b, h) + boff + n * 2048 + k * 1024); } while (0)
#define PG8_MMA(ai, bj, At, Bt) do { __builtin_amdgcn_s_setprio(1); _Pragma("unroll") for (int m = 0; m < 4; ++m) _Pragma("unroll") for (int n = 0; n < 2; ++n) _Pragma("unroll") for (int k = 0; k < 2; ++k) \
        acc[ai][bj][m][n] = __builtin_amdgcn_mfma_f32_16x16x32_bf16(Bt[n][k], At[m][k], acc[ai][bj][m][n], 0, 0, 0); __builtin_amdgcn_s_setprio(0); } while (0)
#define PG8_WAIT_V(n) asm volatile("s_waitcnt vmcnt(" #n ")" ::: "memory")
#define PG8_WAIT_L(n) asm volatile("s_waitcnt lgkmcnt(" #n ")" ::: "memory")
#define PG8_BAR __builtin_amdgcn_s_barrier()
#define PG8_SCHED __builtin_amdgcn_sched_barrier(0)
    Unit cur, nxt; int ui = 0;
    if (!S.next(0, cur)) return;
    LAS float* ptab = (LAS float*)(uintptr_t)(131072 + 8192);
    if constexpr (Epi::HAS_PRE) { E.pre_store(E.pre_load(cur, tid), tid, ptab); asm volatile("s_waitcnt lgkmcnt(0)" ::: "memory"); __builtin_amdgcn_s_barrier(); }
    Acc acc;
#pragma unroll
    for (int a = 0; a < 2; ++a)
#pragma unroll
        for (int b = 0; b < 2; ++b)
#pragma unroll
            for (int m = 0; m < 4; ++m)
#pragma unroll
                for (int n = 0; n < 2; ++n) acc[a][b][m][n] = (f32x4){0.f, 0.f, 0.f, 0.f};
    bf16x8 At[4][2], B0[2][2], B1[2][2];
    const char* cA = (const char*)(cur.kind ? g.A2 : g.A) + (size_t)cur.pm * tstepA; const char* cB = (const char*)(cur.kind ? g.Bt2 : g.Bt) + (size_t)cur.pn * tstepB;
    PG8_STAGE(PG8_SB(0, 0), cB, voffB); PG8_STAGE(PG8_SB(0, 1), cB + hstepB, voffB); PG8_STAGE(PG8_SA(0, 0), cA, voffA); PG8_STAGE(PG8_SA(0, 1), cA + hstepA, voffA);
    if (wr == 1) PG8_BAR;
    PG8_WAIT_V(2); PG8_BAR;
    PG8_STAGE(PG8_SB(1, 0), cB + kstep, voffB); PG8_STAGE(PG8_SA(1, 0), cA + kstep, voffA); PG8_STAGE(PG8_SB(1, 1), cB + hstepB + kstep, voffB);
    PG8_WAIT_V(6); PG8_BAR;
    for (;;) {
        const bool has_next = S.next(ui + 1, nxt);
        const char* nA = has_next ? (const char*)(nxt.kind ? g.A2 : g.A) + (size_t)nxt.pm * tstepA : cA; const char* nB = has_next ? (const char*)(nxt.kind ? g.Bt2 : g.Bt) + (size_t)nxt.pn * tstepB : cB;
        for (int t = 0; t < nt; t += 2) {
            const bool last = (t == nt - 2);
            const char* a1 = cA + (size_t)(t + 1) * kstep;
            const char* a2 = last ? nA : cA + (size_t)(t + 2) * kstep; const char* b2 = last ? nB : cB + (size_t)(t + 2) * kstep;
            const char* a3 = a2 + kstep; const char* b3 = b2 + kstep;
            PG8_LDB(B0, 0, 0); PG8_LDB(B1, 0, 1); PG8_SCHED; PG8_LDA(At, 0, 0); PG8_STAGE(PG8_SA(1, 1), a1 + hstepA, voffA);
            PG8_WAIT_V(8); PG8_WAIT_L(0); PG8_BAR; PG8_MMA(0, 0, At, B0); PG8_MMA(0, 1, At, B1); PG8_BAR; PG8_SCHED;
            PG8_LDA(At, 0, 1); PG8_STAGE(PG8_SB(0, 0), b2, voffB); PG8_STAGE(PG8_SB(0, 1), b2 + hstepB, voffB); PG8_STAGE(PG8_SA(0, 0), a2, voffA);
            PG8_WAIT_V(8); PG8_WAIT_L(0); PG8_BAR; PG8_MMA(1, 0, At, B0); PG8_MMA(1, 1, At, B1); PG8_BAR; PG8_SCHED;
            PG8_LDB(B0, 1, 0); PG8_LDB(B1, 1, 1); PG8_SCHED; PG8_LDA(At, 1, 0); PG8_STAGE(PG8_SA(0, 1), a2 + hstepA, voffA);
            PG8_WAIT_V(8); PG8_WAIT_L(0); PG8_BAR; PG8_MMA(0, 0, At, B0); PG8_MMA(0, 1, At, B1); PG8_BAR; PG8_SCHED;
            PG8_LDA(At, 1, 1); PG8_STAGE(PG8_SB(1, 0), b3, voffB); PG8_STAGE(PG8_SB(1, 1), b3 + hstepB, voffB); PG8_STAGE(PG8_SA(1, 0), a3, voffA);
            PG8_WAIT_V(8); PG8_WAIT_L(0); PG8_BAR; PG8_MMA(1, 0, At, B0); PG8_MMA(1, 1, At, B1); PG8_BAR; PG8_SCHED;
        }
        if (wr == 0) PG8_BAR;
        if constexpr (Epi::HAS_PRE) {
            f32x4 raw = (f32x4){0.f, 0.f, 0.f, 0.f};
            if (has_next) raw = E.pre_load(nxt, tid);
            E(acc, cur, wr, wc, fr, fq, ptab + (ui & 1) * 256);
            if (has_next) E.pre_store(raw, tid, ptab + ((ui + 1) & 1) * 256);
        } else E(acc, cur, wr, wc, fr, fq);
        if (!has_next) break;
#pragma unroll
        for (int a = 0; a < 2; ++a)
#pragma unroll
            for (int b = 0; b < 2; ++b)
#pragma unroll
                for (int m = 0; m < 4; ++m)
#pragma unroll
                    for (int n = 0; n < 2; ++n) acc[a][b][m][n] = (f32x4){0.f, 0.f, 0.f, 0.f};
        cur = nxt; cA = nA; cB = nB; ++ui;
        if (wr == 1) PG8_BAR;
    }
    PG8_WAIT_V(0);
    PG8_BAR;
#undef PG8_SA
#undef PG8_SB
#undef PG8_STAGE
#undef PG8_LDA
#undef PG8_LDB
#undef PG8_MMA
#undef PG8_WAIT_V
#undef PG8_WAIT_L
#undef PG8_BAR
#undef PG8_SCHED
}
}

__device__ __forceinline__ unsigned f2bf(float f) { unsigned u = __builtin_bit_cast(unsigned, f); return (u + 0x7fffu + ((u >> 16) & 1u)) >> 16; }
__device__ __forceinline__ unsigned pk2(float lo, float hi) { return f2bf(lo) | (f2bf(hi) << 16); }
__device__ __forceinline__ int destrow(int mode, int n) {
    if (mode == 1) { const int isu = n >= DFF ? 1 : 0; const int h = n - DFF * isu; return ((h >> 7) << 8) + (isu << 7) + (h & 127); }
    if (mode == 2) return n < 1024 ? n : (n < 2048 ? n + 2048 : n - 1024);
    return n;
}
__device__ __forceinline__ void tr_item(const float* W, int K, int N, bf16_t* WT, int mode, const float* gain, LAS float* scr, int item, int lane) {
    const int nblk = N / 64, kb = item / nblk, nb = item % nblk, k0 = 64 * kb, n0 = 64 * nb;
    const int ln = (lane & 15) * 4, lk = lane >> 4;
#pragma unroll
    for (int i = 0; i < 16; ++i) { const int kk = 4 * i + lk; const f32x4 w = *(const f32x4*)(W + (size_t)(k0 + kk) * N + n0 + ln);
        LAS float* d = scr + kk * 65 + ln; d[0] = w.x; d[1] = w.y; d[2] = w.z; d[3] = w.w; }
    const int c = lane & 7;
    f32x4 g0 = (f32x4){1.f, 1.f, 1.f, 1.f}, g1 = g0;
    if (gain) { g0 = *(const f32x4*)(gain + k0 + 8 * c); g1 = *(const f32x4*)(gain + k0 + 8 * c + 4); }
    LDS_WAIT();
#pragma unroll
    for (int j = 0; j < 8; ++j) { const int n = (lane >> 3) + 8 * j; const LAS float* s = scr + (8 * c) * 65 + n;
        u32x4 o; o.x = pk2(s[0 * 65] * g0.x, s[1 * 65] * g0.y); o.y = pk2(s[2 * 65] * g0.z, s[3 * 65] * g0.w); o.z = pk2(s[4 * 65] * g1.x, s[5 * 65] * g1.y); o.w = pk2(s[6 * 65] * g1.z, s[7 * 65] * g1.w);
        *(u32x4*)(WT + (size_t)destrow(mode, n0 + n) * K + k0 + 8 * c) = o; }
    LDS_WAIT();
}

#define RLX_AGENT __ATOMIC_RELAXED, __HIP_MEMORY_SCOPE_AGENT
#define XB_TMO      128
#define XB_XCNT(j)  (256  + 64 * (j))
#define XB_XSUB(j)  (1280 + 64 * (j))
#define XB_XGEN(j)  (2304 + 64 * (j))
#define XB_TOP      3328
#define XB_TOPGEN   3392
#define XCD_BAR_WORDS 3456
#define XB_SPIN_CAP (1u << 18)

__device__ __forceinline__ unsigned xb_ld(unsigned* p)              { return __hip_atomic_load(p, __ATOMIC_RELAXED, __HIP_MEMORY_SCOPE_AGENT); }
__device__ __forceinline__ unsigned xb_add(unsigned* p, unsigned v) { return __hip_atomic_fetch_add(p, v, __ATOMIC_RELAXED, __HIP_MEMORY_SCOPE_AGENT); }
__device__ __forceinline__ unsigned xb_xcc_id() { return (unsigned)__builtin_amdgcn_s_getreg((3 << 11) | 20) & 0xFu; }
#define XB_SPIN(cond, bar) do { unsigned _sp = 0; while (cond) { __builtin_amdgcn_s_sleep(1); \
    if ((++_sp & 255u) == 0u) { if (xb_ld(&(bar)[XB_TMO])) break; if (_sp > XB_SPIN_CAP) { atomicAdd(&(bar)[XB_TMO], 1u); break; } } } } while (0)

struct XcdBarrier {
    unsigned* bar; unsigned x;
    volatile LAS unsigned* st;
};

__device__ __forceinline__ XcdBarrier xcd_barrier_post(unsigned* bar, volatile LAS unsigned* st) {
    XcdBarrier b; b.bar = bar; b.x = xb_xcc_id(); b.st = st;
    if (threadIdx.x == 0) (void)xb_add(&bar[XB_XCNT(b.x)], 1u);
    return b;
}
__device__ __forceinline__ void xcd_barrier_complete(unsigned* bar, unsigned x, unsigned& nloc, unsigned& nx) {
    const unsigned G = gridDim.x * gridDim.y * gridDim.z;
    unsigned sum, cnt, mine, sp = 0u;
    for (;;) {
        sum = 0u; cnt = 0u; mine = 0u;
#pragma unroll
        for (unsigned j = 0; j < 16; ++j) { const unsigned c = xb_ld(&bar[XB_XCNT(j)]); sum += c; cnt += (c > 0u) ? 1u : 0u; mine = (j == x) ? c : mine; }
        if (sum == G) break;
        __builtin_amdgcn_s_sleep(1);
        if ((++sp & 255u) == 0u) { if (xb_ld(&bar[XB_TMO])) break; if (sp > XB_SPIN_CAP) { atomicAdd(&bar[XB_TMO], 1u); break; } }
    }
    nloc = mine > 0u ? mine : 1u; nx = cnt > 0u ? cnt : 1u;
}

__device__ __forceinline__ void xcd_barrier(const XcdBarrier& b, const int wave_) {
    asm volatile("s_waitcnt vmcnt(0)" ::: "memory");
    __syncthreads();
    if (wave_ == 0 && lane_id_fresh() == 0u) {
        unsigned* bar = b.bar;
        __builtin_amdgcn_s_waitcnt(0);
        unsigned nloc = b.st[0], nx = b.st[1];
        if (nloc == 0u) { xcd_barrier_complete(bar, b.x, nloc, nx); b.st[0] = nloc; b.st[1] = nx; }
        const unsigned old = xb_add(&bar[XB_XSUB(b.x)], 1u);
        const unsigned gen = old / nloc;
        if (old + 1u == (gen + 1u) * nloc) {
            __builtin_amdgcn_fence(__ATOMIC_RELEASE, "agent");
            asm volatile("s_waitcnt vmcnt(0)" ::: "memory");
            const unsigned og = xb_add(&bar[XB_TOP], 1u);
            const unsigned tg = og / nx;
            if (og + 1u == (tg + 1u) * nx) xb_add(&bar[XB_TOPGEN], 1u);
            else XB_SPIN(xb_ld(&bar[XB_TOPGEN]) == tg, bar);
            __builtin_amdgcn_fence(__ATOMIC_ACQUIRE, "agent");
            xb_add(&bar[XB_XGEN(b.x)], 1u);
            asm volatile("s_waitcnt vmcnt(0)" ::: "memory");
        } else {
            XB_SPIN(xb_ld(&bar[XB_XGEN(b.x)]) == gen, bar);
            __builtin_amdgcn_fence(__ATOMIC_ACQUIRE, "agent");
            asm volatile("s_waitcnt vmcnt(0)" ::: "memory");
        }
    }
    __syncthreads();
}


struct Args { const float* in[15]; float* out; unsigned char* ws; };
typedef const __attribute__((address_space(4))) Args* KArgs;

struct TrDesc { const float* W; bf16_t* WT; const float* gain; int K, N, mode, r; };
__device__ __forceinline__ int tr_count(int sel) {
    return ((sel & 1) ? 1408 : 0) + ((sel & 2) ? 1408 : 0) + ((sel & 4) ? 704 : 0) + ((sel & 8) ? 704 : 0) + ((sel & 16) ? 1024 : 0) + ((sel & 32) ? 128 : 0) + ((sel & 64) ? 256 : 0);
}
__device__ __forceinline__ TrDesc tr_desc(KArgs ap, unsigned char* ws, int l, int sel, int item) {
    const int C0 = (sel & 1) ? 1408 : 0, C1 = (sel & 2) ? 1408 : 0, C2 = (sel & 4) ? 704 : 0, C3 = (sel & 8) ? 704 : 0, C4 = (sel & 16) ? 1024 : 0, C5 = (sel & 32) ? 128 : 0;
    TrDesc d; int r = item;
    if (r < C0) { d.W = ap->in[2] + (size_t)l * DM * 2 * DFF; d.WT = (bf16_t*)(ws + WS_W1A); d.gain = ap->in[1] + l * DM; d.K = DM; d.N = 2 * DFF; d.mode = 1; d.r = r; return d; } r -= C0;
    if (r < C1) { d.W = ap->in[12] + (size_t)l * DM * 2 * DFF; d.WT = (bf16_t*)(ws + WS_W1B); d.gain = ap->in[11] + l * DM; d.K = DM; d.N = 2 * DFF; d.mode = 1; d.r = r; return d; } r -= C1;
    if (r < C2) { d.W = ap->in[3] + (size_t)l * DFF * DM; d.WT = (bf16_t*)(ws + WS_W2A); d.gain = nullptr; d.K = DFF; d.N = DM; d.mode = 0; d.r = r; return d; } r -= C2;
    if (r < C3) { d.W = ap->in[13] + (size_t)l * DFF * DM; d.WT = (bf16_t*)(ws + WS_W2B); d.gain = nullptr; d.K = DFF; d.N = DM; d.mode = 0; d.r = r; return d; } r -= C3;
    if (r < C4) { d.W = ap->in[5] + (size_t)l * DM * 4096; d.WT = (bf16_t*)(ws + WS_WIN); d.gain = ap->in[4] + l * DM; d.K = DM; d.N = 4096; d.mode = 2; d.r = r; return d; } r -= C4;
    if (r < C5) { d.W = ap->in[8] + (size_t)l * 512 * DM; d.WT = (bf16_t*)(ws + WS_WNA); d.gain = nullptr; d.K = 512; d.N = DM; d.mode = 0; d.r = r; return d; } r -= C5;
    d.W = ap->in[10] + (size_t)l * DM * DM; d.WT = (bf16_t*)(ws + WS_WO); d.gain = nullptr; d.K = DM; d.N = DM; d.mode = 0; d.r = r; return d;
}
__device__ __forceinline__ void tr_load(const TrDesc& d, f32x4 (&w)[16], int lane) {
    const int nblk = d.N / 64, kb = d.r / nblk, nb = d.r % nblk, k0 = 64 * kb, n0 = 64 * nb;
    const unsigned loff = (unsigned)((lane >> 4) * d.N + (lane & 15) * 4);
    const float* wb = d.W + (size_t)k0 * d.N + n0;
#pragma unroll
    for (int i = 0; i < 16; ++i) w[i] = __builtin_nontemporal_load((const f32x4*)(wb + (size_t)(4 * i) * d.N + loff));
}
__device__ __forceinline__ void tr_store(const TrDesc& d, const f32x4 (&w)[16], LAS float* scr, int lane) {
    const int nblk = d.N / 64, kb = d.r / nblk, nb = d.r % nblk, k0 = 64 * kb, n0 = 64 * nb, ln = (lane & 15) * 4, lk = lane >> 4;
#pragma unroll
    for (int i = 0; i < 16; ++i) { LAS float* p = scr + (4 * i + lk) * 65 + ln; p[0] = w[i].x; p[1] = w[i].y; p[2] = w[i].z; p[3] = w[i].w; }
    const int c = lane & 7;
    f32x4 g0 = (f32x4){1.f, 1.f, 1.f, 1.f}, g1 = g0;
    if (d.gain) { g0 = *(const f32x4*)(d.gain + k0 + 8 * c); g1 = *(const f32x4*)(d.gain + k0 + 8 * c + 4); }
    LDS_WAIT();
#pragma unroll
    for (int j = 0; j < 8; ++j) { const int n = (lane >> 3) + 8 * j; const LAS float* s = scr + (8 * c) * 65 + n;
        u32x4 o; o.x = pk2(s[0 * 65] * g0.x, s[1 * 65] * g0.y); o.y = pk2(s[2 * 65] * g0.z, s[3 * 65] * g0.w); o.z = pk2(s[4 * 65] * g1.x, s[5 * 65] * g1.y); o.w = pk2(s[6 * 65] * g1.z, s[7 * 65] * g1.w);
        *(u32x4*)(d.WT + (size_t)destrow(d.mode, n0 + n) * d.K + k0 + 8 * c) = o; }
    LDS_WAIT();
}
__device__ __forceinline__ void conv_job(KArgs ap, unsigned char* ws, int l, int sel, int gwl, int ngw, LAS float* scr, int lane) {
    const int nit = tr_count(sel);
    for (int item = gwl; item < nit; item += ngw) { const TrDesc d = tr_desc(ap, ws, l, sel, item); f32x4 wa[16]; tr_load(d, wa, lane); tr_store(d, wa, scr, lane); }
}
__device__ __forceinline__ void g_job(const float* wf, bf16_t* Gt, LAS unsigned char* lds, int tid, int lane, int wave, int bxl, int nblk) {
    LAS float* tg = (LAS float*)lds; LAS float* strip = (LAS float*)(lds + 4096);
    __syncthreads();
    if (tid < 128) { tg[tid] = cospif((float)tid * (1.0f / 64.0f)); tg[128 + tid] = sinpif((float)tid * (1.0f / 64.0f)); }
    for (int bi = bxl; bi < 256; bi += nblk) {
        const int nc = bi & 15, g = (bi >> 4) & 3, combo = (bi >> 6) * 8 + wave, ri = combo >> 4, c0 = (combo & 15) * 8, n = nc * 64 + lane;
        __syncthreads();
#pragma unroll
        for (int i = 0; i < 4; ++i) { const int idx = tid + 512 * i, m = idx >> 4, n4 = (idx & 15) * 4;
            *(LAS f32x4*)(strip + m * 64 + n4) = *(const f32x4*)(wf + (size_t)(g * 128 + m) * DM + nc * 64 + n4); }
        __syncthreads();
        const LAS float* tp = tg + ri * 128;
        float acc8[8];
#pragma unroll
        for (int e = 0; e < 8; ++e) acc8[e] = 0.f;
#pragma unroll 8
        for (int m = 0; m < 128; ++m) { const float w = strip[m * 64 + lane];
#pragma unroll
            for (int e = 0; e < 8; ++e) acc8[e] += tp[((c0 + e) * m) & 127] * w; }
        const float sg = 0.08838834764831845f;
        u32x4 o; o.x = pk2(acc8[0] * sg, acc8[1] * sg); o.y = pk2(acc8[2] * sg, acc8[3] * sg); o.z = pk2(acc8[4] * sg, acc8[5] * sg); o.w = pk2(acc8[6] * sg, acc8[7] * sg);
        *(u32x4*)(Gt + (size_t)n * 1024 + ri * 512 + g * 128 + c0) = o;
    }
    __syncthreads();
}

__global__ void __launch_bounds__(512, 2) fwd_kernel(Args a) {
    extern __shared__ __attribute__((aligned(16))) unsigned char lds_raw[];
    LAS unsigned char* lds = (LAS unsigned char*)lds_raw;
    cg::grid_group grid = cg::this_grid();
    const int wave = __builtin_amdgcn_readfirstlane(threadIdx.x >> 6);
#define LAUNDER_TID() int tid = wave * 64 + (int)lane_id_fresh(); asm volatile("" : "+v"(tid)); const int lane = tid & 63
    constexpr int G = 256;
    const int bx0 = blockIdx.x;
    constexpr int NGW = G * 8;
#define PTRS() \
    KArgs ap = (KArgs)__builtin_amdgcn_kernarg_segment_ptr(); asm volatile("" : "+s"(ap)); \
    int bx_l = bx0; asm volatile("" : "+s"(bx_l)); const int bx = bx_l; const int gw = bx * 8 + wave; \
    unsigned char* ws = ap->ws; \
    const float* x_in = ap->in[0]; \
    float* R = ap->out; \
    f32x2* tab = (f32x2*)(ws + WS_TAB); \
    bf16_t* Dt = (bf16_t*)(ws + WS_DT); bf16_t* Eb = (bf16_t*)(ws + WS_EB); \
    float* part = (float*)(ws + WS_PART); \
    bf16_t* W1tA = (bf16_t*)(ws + WS_W1A); bf16_t* W1tB = (bf16_t*)(ws + WS_W1B); \
    bf16_t* W2tA = (bf16_t*)(ws + WS_W2A); bf16_t* W2tB = (bf16_t*)(ws + WS_W2B); \
    bf16_t* Wint = (bf16_t*)(ws + WS_WIN); bf16_t* Wna_t = (bf16_t*)(ws + WS_WNA); bf16_t* Gt = (bf16_t*)(ws + WS_GT); bf16_t* Wo_t = (bf16_t*)(ws + WS_WO); \
    bf16_t* xb = (bf16_t*)(ws + WS_XB); bf16_t* Z = (bf16_t*)(ws + WS_Z); bf16_t* H = (bf16_t*)(ws + WS_H); \
    bf16_t* VU = (bf16_t*)(ws + WS_VU); bf16_t* Ap = xb; bf16_t* Mb = VU; \
    bf16_t* Xa = (bf16_t*)(ws + WS_XA); bf16_t* FW = Xa;
    {
        unsigned* bw = (unsigned*)a.ws;
        if (bx0 == 0) for (int i = threadIdx.x; i < 8192; i += 512) __hip_atomic_store(bw + i, 0u, RLX_AGENT);
        volatile LAS unsigned* misc = (volatile LAS unsigned*)(lds + MISC_OFF);
        if (threadIdx.x < 32) misc[threadIdx.x] = 0u;
        __threadfence();
        grid.sync();
    }
    XcdBarrier xbar = xcd_barrier_post((unsigned*)a.ws, (volatile LAS unsigned*)(lds + MISC_OFF) + 8);
#define GRID_SYNC() xcd_barrier(xbar, wave)

    for (int it = 0; it < 4; ++it) {
        const int l = it >> 1, which = it & 1;
        if (it == 0) {
            for (int rep = 0; rep < 1 + ((PROBE_DUP >> 0) & 1); ++rep) {
            if constexpr ((PHMASK >> 9) & 1) {
                LAUNDER_TID(); PTRS();
                conv_job(ap, ws, 0, 1, gw, NGW, (LAS float*)(lds + wave * 16640), lane);
                g_job(ap->in[9], Gt, lds, tid, lane, wave, bx, 256);
                __syncthreads();
                if (l == 0) {
                    for (int p = bx * 512 + tid; p < 8192; p += G * 512) { const float ang = (float)p * (1.0f / 4096.0f); tab[p] = (f32x2){cospif(ang), sinpif(ang)}; }
                    for (int i = bx * 512 + tid; i < 256 * 128; i += G * 512) {
                        const int row = i >> 7, t1 = i & 127, ri = row >> 7, k1 = row & 127; const float ang = (float)((k1 * t1) & 127) * (1.0f / 64.0f);
                        Dt[i] = (bf16_t)f2bf(ri == 0 ? cospif(ang) : -sinpif(ang));
                    }
                    for (int i = bx * 512 + tid; i < 256 * 256; i += G * 512) {
                        const int row = i >> 8, kap = i & 255, rio = row >> 7, p = (row >> 6) & 1, k2 = row & 63, pp = kap >> 7, rii = (kap >> 6) & 1, t2 = kap & 63;
                        const float ang = (float)((k2 * t2) & 63) * (1.0f / 32.0f); const float cv = cospif(ang), sv = sinpif(ang);
                        float v = 0.f; if (p == pp) v = (rio == 0) ? (rii == 0 ? cv : sv) : (rii == 0 ? -sv : cv);
                        Eb[i] = (bf16_t)f2bf(v);
                    }
                    for (int row = gw; row < NTOK; row += NGW) {
                        const f32x4* xr = (const f32x4*)(x_in + (size_t)row * DM) + lane; float s = 0.f;
                        unsigned long long* o8 = (unsigned long long*)(xb + (size_t)row * DM) + lane;
#pragma unroll
                        for (int j = 0; j < 4; ++j) { const f32x4 v = xr[64 * j]; s += (v.x * v.x + v.y * v.y) + (v.z * v.z + v.w * v.w);
                            o8[64 * j] = (unsigned long long)pk2(v.x, v.y) | ((unsigned long long)pk2(v.z, v.w) << 32); }
                        s = wave_sum(s, lane);
                        if (lane < 4) part[(size_t)row * 4 + lane] = lane == 0 ? s : 0.f;
                    }
                }
            }
            GRID_SYNC(); }
        }
            for (int rep = 0; rep < 1 + ((PROBE_DUP >> 1) & 1); ++rep) {
        {
            PTRS();
            pg8::Gemm g{xb, (which ? W1tB : W1tA), NTOK, 2 * DFF, DM, DM, DM, nullptr, nullptr}; pg8::StaticOrder S; S.init(NTOK, 2 * DFF, G, bx);
            pg8::EpiSwiglu E{H, part};
            if constexpr ((PHMASK >> 0) & 1) pg8::gemm_phase<pg8::EpiSwiglu>(lds, g, S, E, wave);
            if (bx >= 128) {
                LAUNDER_TID();
                const int gwl = (bx - 128) * 8 + wave; LAS float* scr = (LAS float*)(lds + wave * 16640);
                if (it == 0) conv_job(ap, ws, 0, 0x76, gwl, 1024, scr, lane);
                else if (it == 1) { conv_job(ap, ws, 0, 0x08, gwl, 1024, scr, lane); conv_job(ap, ws, 1, 0x71, gwl, 1024, scr, lane); }
                else if (it == 2) conv_job(ap, ws, 1, 0x06, gwl, 1024, scr, lane);
                else conv_job(ap, ws, 1, 0x08, gwl, 1024, scr, lane);
                if (it == 2) g_job(ap->in[9] + (size_t)512 * DM, Gt, lds, tid, lane, wave, bx - 128, 128);
            }
        }
        GRID_SYNC(); }
        for (int rep = 0; rep < 1 + ((PROBE_DUP >> 7) & 1); ++rep) {
        {
            PTRS();
            pg8::Gemm g{H, (which ? W2tB : W2tA), NTOK, DM, DFF, DFF, DFF, nullptr, nullptr}; pg8::StaticOrder S; S.init(NTOK, DM, G, bx);
            const bool probe0 = ((PROBE_DUP >> 7) & 1) && rep == 0;
            if (((PROBE_DUP >> 7) & 1) && probe0) {
                pg8::EpiResid<0, false> E{(it == 0) ? x_in : (const float*)R, R, xb, part, nullptr, nullptr};
                if constexpr ((PROBE_DUP >> 7) & 1) pg8::gemm_phase<pg8::EpiResid<0, false>>(lds, g, S, E, wave);
            } else if (it == 3) {
                pg8::EpiResid<1, true> E{(const float*)R, R, xb, part, ap->in[14], (unsigned*)(ws + 16384)};
                if constexpr ((PHMASK >> 1) & 1) pg8::gemm_phase<pg8::EpiResid<1, true>>(lds, g, S, E, wave);
            } else {
                pg8::EpiResid<1, false> E{(it == 0) ? x_in : (const float*)R, R, xb, part, nullptr, nullptr};
                if constexpr ((PHMASK >> 1) & 1) pg8::gemm_phase<pg8::EpiResid<1, false>>(lds, g, S, E, wave);
            }
        }
        if (it < 3 || ((PROBE_DUP >> 7) & 1)) GRID_SYNC(); }
        if (which == 0) {
            for (int rep = 0; rep < 1 + ((PROBE_DUP >> 2) & 1); ++rep) {
            {
                PTRS();
                pg8::Gemm g{xb, Wint, NTOK, 3072, DM, DM, DM, Wint + (size_t)3072 * DM, xb};
                pg8::DualOrder S; S.s1.init(NTOK, 3072, G, bx); S.s2.init(1024, NTOK, G, bx);
                pg8::EpiInDual E{pg8::EpiMixIn{Z, part, ap->in[6] + (size_t)l * 2048}, pg8::EpiColScale{VU, NTOK, part}};
                if constexpr ((PHMASK >> 2) & 1) pg8::gemm_phase<pg8::EpiInDual, pg8::DualOrder>(lds, g, S, E, wave);
            }
            GRID_SYNC(); }
            for (int rep = 0; rep < 1 + ((PROBE_DUP >> 3) & 1); ++rep) {
            if constexpr ((PHMASK >> 8) & 1) {
                LAUNDER_TID(); PTRS();
                LAS unsigned char* scr = lds + 16384 + wave * 9216;
                for (int item = gw; item < 2048; item += NGW) {
                    const int hq = item & 1, ch = (item >> 1) & 511, b = item >> 10;
                    const bf16_t* src = VU + (size_t)(512 + ch) * NTOK + b * SEQ + hq * 4096;
#pragma unroll
                    for (int i = 0; i < 8; ++i) { const int c = lane + 64 * i; const u32x4 v = *(const u32x4*)(src + c * 8); *(LAS u32x4*)(scr + (c >> 3) * 144 + (c & 7) * 16) = v; }
                    LDS_WAIT();
#pragma unroll
                    for (int ps = 0; ps < 8; ++ps) {
                        const int t2 = 8 * ps + (lane >> 3), q = lane & 7; unsigned e[8];
#pragma unroll
                        for (int k = 0; k < 8; ++k) e[k] = *(const LAS unsigned short*)(scr + (8 * q + k) * 144 + 2 * t2);
                        u32x4 o; o.x = e[0] | (e[1] << 16); o.y = e[2] | (e[3] << 16); o.z = e[4] | (e[5] << 16); o.w = e[6] | (e[7] << 16);
                        *(u32x4*)(Xa + ((size_t)((b * 512 + ch) * 64 + t2)) * 128 + hq * 64 + 8 * q) = o;
                    }
                    LDS_WAIT();
                }
                asm volatile("s_waitcnt vmcnt(0)" ::: "memory"); __syncthreads();
                if constexpr ((PHMASK >> 4) & 1) {
                    pg8::Gemm g{Dt, Xa, 256, 65536, 128, 128, 128, nullptr, nullptr}; pg8::OneUnit S1{bx};
                    pg8::EpiDftA E{Ap, tab, 0.08838834764831845f};
                    pg8::gemm_phase<pg8::EpiDftA, pg8::OneUnit>(lds, g, S1, E, wave);
                }
                LAS float* tb = (LAS float*)lds;
                const float* rpb = ap->in[7] + (size_t)l * 8 * 15 * 31;
                for (int i = tid; i < 8 * 15 * 32; i += 512) tb[i] = ((i & 31) < 31) ? rpb[(i >> 5) * 31 + (i & 31)] * LOG2E : -INFINITY;
                __syncthreads();
                const int q = lane & 15, gq = lane >> 4;
                for (int pass = 0; pass < 4; ++pass) {
                    const int up = pass * 256 + (bx >> 3) * 8 + wave;
                    const int h = bx & 7, j = up & 3, r = (up >> 2) & 127, b = up >> 9;
                    const int rowq = b * SEQ + r * 64 + 16 * j + q;
                    const bf16_t* qp = Z + (size_t)rowq * ZLD + h * 64 + 8 * gq;
                    const bf16x8 qf0 = *(const bf16x8*)qp, qf1 = *(const bf16x8*)(qp + 32);
                    const int rs = min(max(r - 4, 0), 120), bs = min(max(16 * j - 8, 0), 32);
                    f32x4 s[8][2];
                    const int kap_lo = 8 * (q >> 2) + (q & 3);
                    const int G0 = (b * SEQ + rs * 64 + bs) >> 3;
                    const unsigned klane = (unsigned)((q >> 2) * ZLD + (q & 3) * 32 + 8 * gq), vlane = (unsigned)(gq * 512 + q * 8);
                    const bf16_t* kb0 = Z + (size_t)(h * 2048 + G0) * ZLD + 512;
                    const bf16_t* vb0 = VU + (size_t)(h * 2048 + G0) * 512;
                    bf16x8 kf[8][2][2];
#pragma unroll
                    for (int u = 0; u < 8; ++u)
#pragma unroll
                        for (int tau = 0; tau < 2; ++tau) {
                            const bf16_t* kp = kb0 + (size_t)(u * 8) * ZLD + tau * 256 + klane;
                            kf[u][tau][0] = *(const bf16x8*)kp; kf[u][tau][1] = *(const bf16x8*)(kp + 128);
                        }
                    __builtin_amdgcn_sched_barrier(0);
#pragma unroll
                    for (int u = 0; u < 8; ++u)
#pragma unroll
                        for (int tau = 0; tau < 2; ++tau) {
                            f32x4 c = (f32x4){0.f, 0.f, 0.f, 0.f};
                            c = __builtin_amdgcn_mfma_f32_16x16x32_bf16(kf[u][tau][0], qf0, c, 0, 0, 0);
                            c = __builtin_amdgcn_mfma_f32_16x16x32_bf16(kf[u][tau][1], qf1, c, 0, 0, 0);
                            s[u][tau] = c;
                        }
                    __builtin_amdgcn_sched_barrier(0);
                    bf16x8 vf[8][4];
#pragma unroll
                    for (int u = 0; u < 8; ++u)
#pragma unroll
                        for (int mt = 0; mt < 4; ++mt) vf[u][mt] = *(const bf16x8*)(vb0 + (size_t)(u * 8) * 512 + mt * 128 + vlane);
                    __builtin_amdgcn_sched_barrier(0);
                    const int qcol = 16 * j + q, wst = min(max(qcol - 8, 0), 48);
                    int adr[8];
#pragma unroll
                    for (int k = 0; k < 8; ++k) {
                        const int kc = bs + 8 * gq + k; const int dc = min(max(kc - qcol, -15), 15) + 15;
                        adr[k] = ((h * 15 + (rs - r + 7)) * 32 + ((kc < wst || kc >= wst + 16) ? 31 : dc)) * 4;
                    }
                    float mx = -INFINITY;
#pragma unroll
                    for (int u = 0; u < 8; ++u)
#pragma unroll
                        for (int tau = 0; tau < 2; ++tau)
#pragma unroll
                            for (int i = 0; i < 4; ++i) {
                                const float bias = *(const LAS float*)((const LAS unsigned char*)tb + adr[4 * tau + i] + u * 128);
                                const float v = s[u][tau][i] * (0.125f * LOG2E) + bias;
                                s[u][tau][i] = v; mx = fmaxf(mx, v);
                            }
                    mx = fmaxf(mx, sx(mx, 16, lane)); mx = fmaxf(mx, sx(mx, 32, lane));
                    float sum = 0.f;
#pragma unroll
                    for (int u = 0; u < 8; ++u)
#pragma unroll
                        for (int tau = 0; tau < 2; ++tau)
#pragma unroll
                            for (int i = 0; i < 4; ++i) { const float p = fast_exp2(s[u][tau][i] - mx); s[u][tau][i] = p; sum += p; }
                    sum += sx(sum, 16, lane); sum += sx(sum, 32, lane);
                    f32x4 o[4];
#pragma unroll
                    for (int mt = 0; mt < 4; ++mt) o[mt] = (f32x4){0.f, 0.f, 0.f, 0.f};
#pragma unroll
                    for (int u = 0; u < 8; ++u) {
                        const u32x4 pw = pg8::pack8(s[u][0], s[u][1]);
                        const bf16x8 pb = __builtin_bit_cast(bf16x8, pw);
#pragma unroll
                        for (int mt = 0; mt < 4; ++mt) {
                            o[mt] = __builtin_amdgcn_mfma_f32_16x16x32_bf16(vf[u][mt], pb, o[mt], 0, 0, 0);
                        }
                    }
                    const float inv = 1.0f / sum;
                    if (((PROBE_DUP >> 3) & 1) && rep == 0 && inv > 0.f) continue;
#pragma unroll
                    for (int mt = 0; mt < 4; ++mt) {
                        u32x2 w; w.x = cvt_pk_bf16(o[mt][0] * inv, o[mt][1] * inv); w.y = cvt_pk_bf16(o[mt][2] * inv, o[mt][3] * inv);
                        *(u32x2*)(Z + (size_t)rowq * ZLD + h * 64 + 16 * mt + 4 * gq) = w;
                    }
                }
                __syncthreads();
            }
            GRID_SYNC(); }
            for (int rep = 0; rep < 1 + ((PROBE_DUP >> 5) & 1); ++rep) {
            {
                PTRS();
                pg8::Gemm g{Eb, Ap, 256, 65536, 256, 256, 256, nullptr, nullptr}; pg8::StaticOrder S; S.init(256, 65536, G, bx);
                pg8::EpiDftB E{FW, 0.125f};
                if constexpr ((PHMASK >> 5) & 1) pg8::gemm_phase<pg8::EpiDftB>(lds, g, S, E, wave);
            }
            GRID_SYNC(); }
            for (int rep = 0; rep < 1 + ((PROBE_DUP >> 6) & 1); ++rep) {
            {
                PTRS();
                pg8::Gemm g{Z, Wna_t, NTOK, DM, 512, ZLD, 512, nullptr, nullptr}; pg8::StaticOrder S; S.init(NTOK, DM, G, bx);
                pg8::EpiGate<false> E{Z + 1024, Mb};
                if constexpr ((PHMASK >> 6) & 1) pg8::gemm_phase<pg8::EpiGate<false>>(lds, g, S, E, wave);
            }
            {
                PTRS();
                pg8::Gemm g{FW, Gt, NTOK, DM, DM, DM, DM, nullptr, nullptr}; pg8::StaticOrder S; S.init(NTOK, DM, G, bx);
                pg8::EpiGate<true> E{Z + 2048, Mb};
                if constexpr ((PHMASK >> 7) & 1) pg8::gemm_phase<pg8::EpiGate<true>>(lds, g, S, E, wave);
            }
            GRID_SYNC(); }
            for (int rep = 0; rep < 1 + ((PROBE_DUP >> 8) & 1); ++rep) {
            {
                PTRS();
                pg8::Gemm g{Mb, Wo_t, NTOK, DM, DM, DM, DM, nullptr, nullptr}; pg8::StaticOrder S; S.init(NTOK, DM, G, bx);
                if (((PROBE_DUP >> 8) & 1) && rep == 0) {
                    pg8::EpiResid<0, false> E{R, R, xb, part, nullptr, nullptr};
                    if constexpr ((PROBE_DUP >> 8) & 1) pg8::gemm_phase<pg8::EpiResid<0, false>>(lds, g, S, E, wave);
                } else {
                    pg8::EpiResid<2, false> E{R, R, xb, part, nullptr, nullptr};
                    if constexpr ((PHMASK >> 1) & 1) pg8::gemm_phase<pg8::EpiResid<2, false>>(lds, g, S, E, wave);
                }
            }
            GRID_SYNC(); }
        }
    }
#ifdef PROBE_SYNC
    for (int i = 0; i < PROBE_SYNC; ++i) GRID_SYNC();
#endif
}

extern "C" void kernel_launch(void* const* d_in, const int* in_sizes, int n_in, void* d_out, int out_size, void* d_ws, size_t ws_size, hipStream_t stream) {
    static int grid = 0;
    if (grid == 0) {
        if (n_in != 15 || out_size != NTOK * DM || ws_size < WS_END) { fprintf(stderr, "kernel_launch: unexpected shapes (n_in %d out %d ws %zu)\n", n_in, out_size, ws_size); grid = -1; return; }
        int dev = 0, cus = 0, per_cu = 0;
        hipGetDevice(&dev); hipDeviceGetAttribute(&cus, hipDeviceAttributeMultiprocessorCount, dev);
        if (hipFuncSetAttribute((const void*)fwd_kernel, hipFuncAttributeMaxDynamicSharedMemorySize, LDS_BYTES) != hipSuccess) { fprintf(stderr, "kernel_launch: hipFuncSetAttribute failed\n"); grid = -1; return; }
        if (hipOccupancyMaxActiveBlocksPerMultiprocessor(&per_cu, (const void*)fwd_kernel, 512, LDS_BYTES) != hipSuccess || per_cu < 1) { fprintf(stderr, "kernel_launch: occupancy query says %d\n", per_cu); (void)hipGetLastError(); grid = -1; return; }
        if (cus * per_cu < 256) { fprintf(stderr, "kernel_launch: needs 256 co-resident workgroups, device holds %d\n", cus * per_cu); grid = -1; return; }
        grid = 256;
    }
    if (grid < 0) return;
    Args a{};
    for (int i = 0; i < 15; ++i) a.in[i] = (const float*)d_in[i];
    a.out = (float*)d_out; a.ws = (unsigned char*)d_ws;
    void* args[] = {&a};
    hipError_t e = hipLaunchCooperativeKernel((const void*)fwd_kernel, dim3(grid), dim3(512), args, LDS_BYTES, stream);
    if (e != hipSuccess) fprintf(stderr, "cooperative launch failed: %s (grid %d)\n", hipGetErrorString(e), grid);
}
```
